# Optimizing an MI355X kernel written in HIP

```python
import math
import jax, jax.numpy as jnp
from jax import lax
import numpy as np

D_MODEL = 1024
BATCH = 32
SEQ = 256
DEPTH = 2
DEC_BATCH = 2
DEC_SEQ = 1024
PAST_LEN = 256

GRID_W = 64
MIX_W = D_MODEL
N_MIXERS = 4
GROUP_W = MIX_W // N_MIXERS
CONV_GROUPS = 4
GLA_HEADS = 4
GLA_DK = GROUP_W // (2 * GLA_HEADS)
GLA_DV = GROUP_W // GLA_HEADS
GLA_RANK = 16
GLA_CHUNK = 64
GLA_NORMALIZER = 16.0
MLP_CHUNK = 128
MLP_GROUPS = 4
MLP_GW = GROUP_W // MLP_GROUPS
HY_ORDER = 2
HY_BANDS = 8
HY_EMB = 1 + 2 * HY_BANDS
HY_HIDDEN = 64
D_FF = ((8 * D_MODEL + 2) // 3 + 255) // 256 * 256
NORM_EPS = 1e-6

A_COLS = 3 * GROUP_W
B_COLS = 2 * GLA_HEADS * GLA_DK + 2 * GROUP_W + 2 * GLA_RANK
C_COLS = 2 * GROUP_W
D_COLS = (HY_ORDER + 1) * GROUP_W
IN_COLS = A_COLS + B_COLS + C_COLS + D_COLS

kernel_name = 'hybrid_diffusion_parallel_groups_step'


def rmsnorm(x, g):
    xf = x.astype(jnp.float32)
    y = xf * lax.rsqrt(jnp.mean(xf * xf, axis=-1, keepdims=True) + NORM_EPS)
    return (y * g).astype(x.dtype)


def layernorm(x, g):
    xf = x.astype(jnp.float32)
    mu = jnp.mean(xf, axis=-1, keepdims=True)
    var = jnp.mean(jnp.square(xf - mu), axis=-1, keepdims=True)
    return ((xf - mu) * lax.rsqrt(var + NORM_EPS) * g).astype(x.dtype)


def row_conv3(x, w, row_w):
    bsz, L, C = x.shape
    rows = L // row_w
    xp = jnp.pad(x.reshape(bsz, rows, row_w, C), ((0, 0), (0, 0), (1, 1), (0, 0)))
    y = xp[:, :, :-2] * w[0] + xp[:, :, 1:-1] * w[1] + xp[:, :, 2:] * w[2]
    return y.reshape(bsz, L, C)


def short_conv_mixer(p, conv_w, row_w):
    b_gate, c_gate, xa = jnp.split(p, 3, axis=-1)
    return b_gate * row_conv3(c_gate * xa, conv_w, row_w)


def gla_chunked(q, k, v, la, s0):
    bsz, L, H, K = q.shape
    V = v.shape[-1]
    n = L // GLA_CHUNK
    q, k, v, la = (t.astype(jnp.float32).reshape(bsz, n, GLA_CHUNK, H, t.shape[-1]) for t in (q, k, v, la))
    b = jnp.cumsum(la, axis=2)
    b_last = b[:, :, -1]
    lower = jnp.tril(jnp.ones((GLA_CHUNK, GLA_CHUNK), dtype=bool))
    diff = b[:, :, :, None] - b[:, :, None, :]
    decay = jnp.exp(jnp.where(lower[:, :, None, None], diff, -jnp.inf))
    scores = jnp.einsum('bnihk,bnjhk,bnijhk->bnhij', q, k, decay)
    o_intra = jnp.einsum('bnhij,bnjhv->bnihv', scores, v)
    u_chunk = jnp.einsum('bnjhk,bnjhv->bnhkv', k * jnp.exp(b_last[:, :, None] - b), v)
    a_chunk = jnp.exp(b_last)

    def step(s, inp):
        a_c, u_c = inp
        return a_c[..., None] * s + u_c, s

    s_fin, s_start = lax.scan(step, s0.astype(jnp.float32),
                              (jnp.moveaxis(a_chunk, 1, 0), jnp.moveaxis(u_chunk, 1, 0)))
    s_start = jnp.moveaxis(s_start, 0, 1)
    o_inter = jnp.einsum('bnihk,bnhkv->bnihv', q * jnp.exp(b), s_start)
    return (o_intra + o_inter).reshape(bsz, L, H, V), s_fin


def gla_mixer(p, s0, wgk, bgk, gnorm):
    bsz, L, _ = p.shape
    qk = GLA_HEADS * GLA_DK
    q = p[..., :qk].reshape(bsz, L, GLA_HEADS, GLA_DK) * (GLA_DK ** -0.5)
    k = p[..., qk:2 * qk].reshape(bsz, L, GLA_HEADS, GLA_DK)
    v = p[..., 2 * qk:2 * qk + GROUP_W].reshape(bsz, L, GLA_HEADS, GLA_DV)
    g = p[..., 2 * qk + GROUP_W:2 * qk + 2 * GROUP_W]
    gk_low = p[..., 2 * qk + 2 * GROUP_W:].reshape(bsz, L, 2, GLA_RANK)
    la = jax.nn.log_sigmoid(jnp.einsum('bldr,drk->bldk', gk_low, wgk) + bgk) / GLA_NORMALIZER
    la = la.reshape(bsz, L, 2, GLA_HEADS, GLA_DK)
    o_f, s_f = gla_chunked(q, k, v, la[:, :, 0], s0[:, 0])
    o_b, s_b = gla_chunked(q[:, ::-1], k[:, ::-1], v[:, ::-1], la[:, ::-1, 1], s0[:, 1])
    o = rmsnorm(o_f + o_b[:, ::-1], gnorm).reshape(bsz, L, GROUP_W)
    return o * jax.nn.silu(g.astype(jnp.float32)), jnp.stack([s_f, s_b], axis=1)


def chunk_mlp_mixer(p, ln_g, ws, bs):
    bsz, L, _ = p.shape
    u, vv = jnp.split(jax.nn.gelu(p), 2, axis=-1)
    vv = layernorm(vv, ln_g).reshape(bsz, L // MLP_CHUNK, MLP_CHUNK, MLP_GROUPS, MLP_GW)
    sp = jnp.einsum('gij,bnjgc->bnigc', ws, vv) + bs.T[None, None, :, :, None]
    return u * sp.reshape(bsz, L, GROUP_W)


def hyena_filters(L, w1, b1, freq, w2, b2, w3, log_decay):
    pos = jnp.arange(L, dtype=jnp.float32)
    t = pos / max(L - 1, 1)
    omega = 2.0 * math.pi * pos / L
    bands = jnp.linspace(1e-4, HY_BANDS - 1, HY_BANDS, dtype=jnp.float32)
    feat = jnp.concatenate([t[:, None], jnp.cos(omega[:, None] * bands), jnp.sin(omega[:, None] * bands)], axis=-1)
    h = jnp.sin(freq * (feat @ w1 + b1))
    h = jnp.sin(freq * (h @ w2 + b2))
    h = (h @ w3).reshape(L, 2, HY_ORDER, GROUP_W).astype(jnp.float32)
    h = h * jnp.exp(-jnp.exp(log_decay)[None] * t[:, None, None, None])
    h_fwd = h[:, 0]
    h_bwd = h[:, 1] * (pos > 0)[:, None, None]
    return h_fwd, h_bwd


def bidir_long_conv(z, h_f, h_b, bias):
    L = z.shape[1]
    n = 2 * L
    zf = z.astype(jnp.float32)
    y_f = jnp.fft.irfft(jnp.fft.rfft(zf, n=n, axis=1) * jnp.fft.rfft(h_f, n=n, axis=0)[None], n=n, axis=1)[:, :L]
    y_b = jnp.fft.irfft(jnp.fft.rfft(zf[:, ::-1], n=n, axis=1) * jnp.fft.rfft(h_b, n=n, axis=0)[None], n=n, axis=1)[:, :L]
    return y_f + y_b[:, ::-1] + zf * bias


def hyena_mixer(p, row_w, conv_w, w1, b1, freq, w2, b2, w3, log_decay, hbias):
    L = p.shape[1]
    pc = row_conv3(p, conv_w, row_w)
    x1, x2, z = jnp.split(pc, 3, axis=-1)
    h_f, h_b = hyena_filters(L, w1, b1, freq, w2, b2, w3, log_decay)
    gates = (x1, x2)
    for o in range(HY_ORDER):
        z = gates[o] * bidir_long_conv(z, h_f[:, o], h_b[:, o], hbias[o])
    return z


def trunk_layer(x, cvec, s0, row_w, lp):
    mod = jax.nn.silu(cvec) @ lp['w_mod'] + lp['b_mod']
    sh1, sc1, g1, sh2, sc2, g2 = jnp.split(mod[:, None, :], 6, axis=-1)
    h = rmsnorm(x, lp['g_pre1']) * (1.0 + sc1) + sh1
    p = h @ lp['w_in']
    o1, o2, o3 = A_COLS, A_COLS + B_COLS, A_COLS + B_COLS + C_COLS
    ya = short_conv_mixer(p[..., :o1], lp['conv_a'], row_w)
    yb, s_new = gla_mixer(p[..., o1:o2], s0, lp['gla_wgk'], lp['gla_bgk'], lp['gla_gnorm'])
    yc = chunk_mlp_mixer(p[..., o2:o3], lp['mlp_ln'], lp['mlp_ws'], lp['mlp_bs'])
    yd = hyena_mixer(p[..., o3:], row_w, lp['hy_conv'], lp['hy_w1'], lp['hy_b1'], lp['hy_freq'],
                     lp['hy_w2'], lp['hy_b2'], lp['hy_w3'], lp['hy_log_decay'], lp['hy_bias'])
    m = jnp.concatenate([ya, yb, yc, yd], axis=-1) @ lp['w_out']
    x = x + g1 * rmsnorm(m, lp['g_post1'])
    h = rmsnorm(x, lp['g_pre2']) * (1.0 + sc2) + sh2
    f = (jax.nn.silu(h @ lp['ffn_w1']) * (h @ lp['ffn_w3'])) @ lp['ffn_w2']
    x = x + g2 * rmsnorm(f, lp['g_post2'])
    return x, s_new


def setup_inputs(seed: int = 0) -> dict:
    key = jax.random.key(seed)
    ks = jax.random.split(key, 32)
    f32 = jnp.float32

    def nrm(i, shape, s):
        return jax.random.normal(ks[i], shape, f32) * s

    return {
        'x_prompt': nrm(0, (BATCH, SEQ, D_MODEL), 1.0),
        'x_sample': nrm(1, (DEC_BATCH, DEC_SEQ, D_MODEL), 1.0),
        'state_gla': nrm(2, (DEC_BATCH, DEPTH, 2, GLA_HEADS, GLA_DK, GLA_DV), 0.5),
        'c': nrm(3, (DEC_BATCH, D_MODEL), 1.0),
        'c_ctx': nrm(4, (D_MODEL,), 1.0),
        'w_mod': nrm(5, (DEPTH, D_MODEL, 6 * D_MODEL), D_MODEL ** -0.5),
        'b_mod': nrm(6, (DEPTH, 6 * D_MODEL), 0.02),
        'g_pre1': 1.0 + nrm(7, (DEPTH, D_MODEL), 0.05),
        'g_post1': 1.0 + nrm(8, (DEPTH, D_MODEL), 0.05),
        'g_pre2': 1.0 + nrm(9, (DEPTH, D_MODEL), 0.05),
        'g_post2': 1.0 + nrm(10, (DEPTH, D_MODEL), 0.05),
        'w_in': nrm(11, (DEPTH, D_MODEL, IN_COLS), D_MODEL ** -0.5),
        'conv_a': nrm(12, (DEPTH, 3, GROUP_W), 3 ** -0.5),
        'gla_wgk': nrm(13, (DEPTH, 2, GLA_RANK, GLA_HEADS * GLA_DK), GLA_RANK ** -0.5),
        'gla_bgk': nrm(14, (DEPTH, 2, GLA_HEADS * GLA_DK), 0.1),
        'gla_gnorm': 1.0 + nrm(15, (DEPTH, GLA_DV), 0.05),
        'mlp_ln': 1.0 + nrm(16, (DEPTH, GROUP_W), 0.05),
        'mlp_ws': nrm(17, (DEPTH, MLP_GROUPS, MLP_CHUNK, MLP_CHUNK), MLP_CHUNK ** -0.5),
        'mlp_bs': 1.0 + nrm(18, (DEPTH, MLP_GROUPS, MLP_CHUNK), 0.1),
        'hy_conv': nrm(19, (DEPTH, 3, D_COLS), 3 ** -0.5),
        'hy_w1': nrm(20, (DEPTH, HY_EMB, HY_HIDDEN), HY_EMB ** -0.5),
        'hy_b1': nrm(21, (DEPTH, HY_HIDDEN), 0.1),
        'hy_freq': 1.0 + nrm(22, (DEPTH, HY_HIDDEN), 0.1),
        'hy_w2': nrm(23, (DEPTH, HY_HIDDEN, HY_HIDDEN), HY_HIDDEN ** -0.5),
        'hy_b2': nrm(24, (DEPTH, HY_HIDDEN), 0.1),
        'hy_w3': nrm(25, (DEPTH, HY_HIDDEN, 2 * HY_ORDER * GROUP_W), 0.02),
        'hy_log_decay': jax.random.uniform(ks[26], (DEPTH, 2, HY_ORDER, GROUP_W), f32, math.log(3.0), math.log(15.0)),
        'hy_bias': nrm(27, (DEPTH, HY_ORDER, GROUP_W), 0.5),
        'w_out': nrm(28, (DEPTH, MIX_W, D_MODEL), MIX_W ** -0.5),
        'ffn_w1': nrm(29, (DEPTH, D_MODEL, D_FF), D_MODEL ** -0.5),
        'ffn_w3': nrm(30, (DEPTH, D_MODEL, D_FF), D_MODEL ** -0.5),
        'ffn_w2': nrm(31, (DEPTH, D_FF, D_MODEL), D_FF ** -0.5),
    }


def reference(x_prompt, x_sample, state_gla, c, c_ctx, w_mod, b_mod, g_pre1, g_post1, g_pre2, g_post2,
              w_in, conv_a, gla_wgk, gla_bgk, gla_gnorm, mlp_ln, mlp_ws, mlp_bs, hy_conv, hy_w1, hy_b1,
              hy_freq, hy_w2, hy_b2, hy_w3, hy_log_decay, hy_bias, w_out, ffn_w1, ffn_w3, ffn_w2):
    ctx_len = x_prompt.shape[1]
    s0_ctx = jnp.zeros((x_prompt.shape[0], 2, GLA_HEADS, GLA_DK, GLA_DV), jnp.float32)
    xc, xs = x_prompt, x_sample
    new_states = []
    for l in range(DEPTH):
        lp = dict(w_mod=w_mod[l], b_mod=b_mod[l], g_pre1=g_pre1[l], g_post1=g_post1[l],
                  g_pre2=g_pre2[l], g_post2=g_post2[l], w_in=w_in[l], conv_a=conv_a[l],
                  gla_wgk=gla_wgk[l], gla_bgk=gla_bgk[l], gla_gnorm=gla_gnorm[l],
                  mlp_ln=mlp_ln[l], mlp_ws=mlp_ws[l], mlp_bs=mlp_bs[l], hy_conv=hy_conv[l],
                  hy_w1=hy_w1[l], hy_b1=hy_b1[l], hy_freq=hy_freq[l], hy_w2=hy_w2[l], hy_b2=hy_b2[l],
                  hy_w3=hy_w3[l], hy_log_decay=hy_log_decay[l], hy_bias=hy_bias[l], w_out=w_out[l],
                  ffn_w1=ffn_w1[l], ffn_w3=ffn_w3[l], ffn_w2=ffn_w2[l])
        xc, s_ctx = trunk_layer(xc, c_ctx[None, :], s0_ctx, ctx_len, lp)
        new_states.append(s_ctx)
        xs, _ = trunk_layer(xs, c, state_gla[:, l], GRID_W, lp)
    new_state_gla = jnp.stack(new_states, axis=1)
    return (xc, xs, new_state_gla)
```

```cpp
#include <hip/hip_runtime.h>
#include <cstdio>
#include <cstdint>
namespace pg8 {
#define PG8_LAS __attribute__((address_space(3)))
typedef unsigned short bf16_t;
typedef short bf16x8 __attribute__((ext_vector_type(8)));
typedef float f32x4 __attribute__((ext_vector_type(4)));
typedef unsigned u32x4 __attribute__((ext_vector_type(4)));
constexpr int BM = 256, BK = 64, HALF = 128, HTB = HALF * BK * 2  , STAGE_BYTES = 8 * HTB, NXCD = 8, WGM = 8;

__host__ __device__ __forceinline__ int lds_byte(int r, int c) { const int st = (r >> 4) * 2 + (c >> 5), rr = r & 15, cc = c & 31, ob = rr * 64 + cc * 2; return st * 1024 + (ob ^ (((ob >> 9) & 1) << 5)); }
__host__ __device__ __forceinline__ void stage_rc(int b, int& R, int& C) { const int st = b / 1024, sb = b % 1024, swz = sb ^ (((sb >> 9) & 1) << 5); R = (st >> 1) * 16 + swz / 64; C = (st & 1) * 32 + (swz % 64) / 2; }
__host__ __device__ __forceinline__ int perm32(int rho) { const int n = rho >> 4, i = rho & 15; return 8 * (i >> 2) + 4 * n + (i & 3); }

struct Unit { int pm, pn; };
struct Gemm { const bf16_t* A; const bf16_t* Bt; int M, N, K; };

struct StaticOrder {
    int nM, nN, nwg, G, c;
    __host__ __device__ void init(int M, int N, int G_, int c_) { nM = M / BM; nN = N / BM; nwg = nM * nN; G = G_; c = c_; }
    __host__ __device__ bool next(int i, Unit& u) const {
        const long L = (long)i * G + c; if (L >= nwg) return false;
        int wgid = (int)L; { const int q = nwg / NXCD, r = nwg % NXCD, xcd = wgid % NXCD, off = wgid / NXCD; wgid = (xcd < r ? xcd * (q + 1) : r * (q + 1) + (xcd - r) * q) + off; }
        const int nig = WGM * nN, gid = wgid / nig, fm = gid * WGM, gsz = (nM - fm) < WGM ? (nM - fm) : WGM;
        u.pm = fm + ((wgid % nig) % gsz); u.pn = (wgid % nig) / gsz; return true;
    }
    __device__ __forceinline__ void a_ready(const Unit&) const {}
    __device__ __forceinline__ void done(const Unit&) const {}
};

__device__ __forceinline__ unsigned cvt_pk_bf16(float lo, float hi) { unsigned r; asm volatile("v_cvt_pk_bf16_f32 %0, %1, %2" : "=v"(r) : "v"(lo), "v"(hi)); return r; }
typedef float f32x2 __attribute__((ext_vector_type(2)));
__device__ __forceinline__ f32x2 gelu_pk(f32x2 v) {
    const f32x2 av = __builtin_elementwise_abs(v), d = av * 0.2316418882f + 1.0f;
    f32x2 t; t.x = __builtin_amdgcn_rcpf(d.x); t.y = __builtin_amdgcn_rcpf(d.y);
    f32x2 q = t * 0.5307027145f + (-0.7265760135f); q = q * t + 0.7107068705f; q = q * t + (-0.142248368f); q = q * t + 0.127414796f; q = q * t;
    const f32x2 s = (v * v) * (-0.72134752044f);
    f32x2 e; e.x = __builtin_amdgcn_exp2f(s.x); e.y = __builtin_amdgcn_exp2f(s.y);
    const f32x2 m = v * (q * e), r = v - m;
    f32x2 o; o.x = v.x < 0.f ? m.x : r.x; o.y = v.y < 0.f ? m.y : r.y; return o;
}

template <int ACT  > struct EpiBf16 {
    static constexpr bool PERM = true, AFTER_DRAIN = false; static_assert(ACT == 0 || ACT == 1, "EpiBf16: ACT is 0 (none) or 1 (gelu_pk)");
    bf16_t* O; int ldc; const float* bias; int split_cols; size_t split_stride; float scale0;
    __device__ __forceinline__ void operator()(const f32x4 (&acc)[2][2][4][2], const Unit& u, int wr, int wc, int fr, int fq) const {
        const int row0 = u.pm * BM + wr * 64 + fr; int colt = u.pn * BM; bf16_t* base = O;
        float sc = 1.f; if (split_cols) { const int t = colt / split_cols; base += (size_t)t * split_stride; colt -= t * split_cols; if (t == 0) sc = scale0; }
        const int col0 = colt + wc * 32 + 8 * fq, bcol0 = u.pn * BM + wc * 32 + 8 * fq;
        f32x4 bv[2][2];
#pragma unroll
        for (int bj = 0; bj < 2; ++bj)
#pragma unroll
            for (int n = 0; n < 2; ++n) bv[bj][n] = bias ? *(const f32x4*)(bias + bcol0 + bj * HALF + 4 * n) : (f32x4){0.f, 0.f, 0.f, 0.f};
#pragma unroll
        for (int ai = 0; ai < 2; ++ai)
#pragma unroll
            for (int m = 0; m < 4; ++m) { bf16_t* rowp = base + (size_t)(row0 + ai * HALF + m * 16) * ldc + col0;
#pragma unroll
                for (int bj = 0; bj < 2; ++bj) { f32x4 v0 = acc[ai][bj][m][0] + bv[bj][0], v1 = acc[ai][bj][m][1] + bv[bj][1];
                    if (ACT == 1) { f32x2 a = gelu_pk((f32x2){v0[0], v0[1]}), b = gelu_pk((f32x2){v0[2], v0[3]}), c = gelu_pk((f32x2){v1[0], v1[1]}), d = gelu_pk((f32x2){v1[2], v1[3]});
                        v0 = (f32x4){a.x, a.y, b.x, b.y}; v1 = (f32x4){c.x, c.y, d.x, d.y}; }
                    v0 = v0 * sc; v1 = v1 * sc; u32x4 w; w.x = cvt_pk_bf16(v0[0], v0[1]); w.y = cvt_pk_bf16(v0[2], v0[3]); w.z = cvt_pk_bf16(v1[0], v1[1]); w.w = cvt_pk_bf16(v1[2], v1[3]);
                    *(u32x4*)(rowp + bj * HALF) = w; } }
    }
};

struct PanelStats {
    unsigned* xbuf;
    unsigned* cnt;
    unsigned* tmo;
    int ntn; float eps;
    unsigned code;
    __device__ __forceinline__ bool run(const f32x4 (&v)[2][2][4][2], const Unit& u, int wr, int wc, int fr, int fq, PG8_LAS unsigned char* lds, int wid, int lane) const {
        typedef float f32x2v __attribute__((ext_vector_type(2)));
        PG8_LAS f32x2v* P = (PG8_LAS f32x2v*)lds;
        PG8_LAS f32x2v* S = (PG8_LAS f32x2v*)(lds + 8192);
        PG8_LAS unsigned* flag = (PG8_LAS unsigned*)(lds + 8192 + 2048);
#pragma unroll
        for (int ai = 0; ai < 2; ++ai)
#pragma unroll
            for (int m = 0; m < 4; ++m) {
                float s = 0.f;
#pragma unroll
                for (int bj = 0; bj < 2; ++bj)
#pragma unroll
                    for (int n = 0; n < 2; ++n) { const f32x4 x = v[ai][bj][m][n]; s += (x[0] + x[1]) + (x[2] + x[3]); }
                s += __shfl_xor(s, 16); s += __shfl_xor(s, 32);
                const float mw = s * (1.0f / 64.0f); float q = 0.f;
#pragma unroll
                for (int bj = 0; bj < 2; ++bj)
#pragma unroll
                    for (int n = 0; n < 2; ++n) { const f32x4 d = v[ai][bj][m][n] - mw; q += (d[0] * d[0] + d[1] * d[1]) + (d[2] * d[2] + d[3] * d[3]); }
                q += __shfl_xor(q, 16); q += __shfl_xor(q, 32);
                if (fq == 0) P[(ai * HALF + wr * 64 + m * 16 + fr) * 4 + wc] = (f32x2v){mw, q};
            }
        asm volatile("s_waitcnt lgkmcnt(0)" ::: "memory"); __builtin_amdgcn_s_barrier(); asm volatile("" ::: "memory");
#if defined(BROKEN_EXCHANGE_NO_WAIT)
#warning BROKEN CONTROL BUILD: the row-statistics exchange does not wait; results are wrong by design
        if (blockIdx.x >= 64) { const long long t0_ = clock64(); while (clock64() - t0_ < 60000) __builtin_amdgcn_s_sleep(8); }
#endif
        const int row = wid * 32 + (lane & 31);
        if (lane < 32) {
            const f32x2v a = P[row * 4 + 0], b = P[row * 4 + 1], c = P[row * 4 + 2], d = P[row * 4 + 3];
            const float mt = (a.x + b.x + c.x + d.x) * 0.25f;
            const float da = a.x - mt, db = b.x - mt, dc = c.x - mt, dd = d.x - mt;
            const float m2 = (a.y + b.y) + (c.y + d.y) + 64.0f * ((da * da + db * db) + (dc * dc + dd * dd));
            unsigned long long* slot = (unsigned long long*)xbuf + ((size_t)(u.pm * BM + row) * 4 + u.pn);
            __hip_atomic_store(slot, ((unsigned long long)__float_as_uint(m2) << 32) | __float_as_uint(mt), __ATOMIC_RELAXED, __HIP_MEMORY_SCOPE_AGENT);
        }
        asm volatile("s_waitcnt vmcnt(0)" ::: "memory");
        if (lane == 0) __hip_atomic_fetch_add(cnt + 64 * u.pm, 1u, __ATOMIC_RELAXED, __HIP_MEMORY_SCOPE_AGENT);
        if (wid == 0) {
            bool dead = false; const unsigned long long t0 = __builtin_amdgcn_s_memrealtime(); const unsigned want = 8u * (unsigned)ntn;
            for (;;) {
#if defined(BROKEN_EXCHANGE_NO_WAIT)
                break;
#endif
                if ((unsigned)__builtin_amdgcn_readfirstlane(__hip_atomic_load(cnt + 64 * u.pm, __ATOMIC_RELAXED, __HIP_MEMORY_SCOPE_AGENT)) >= want) break;
                if (__builtin_amdgcn_s_memrealtime() - t0 > 2000000ull) {
                    if (lane == 0) { unsigned expect = 0u; __hip_atomic_compare_exchange_strong(tmo + 1, &expect, code | (unsigned)(u.pm & 0xff), __ATOMIC_RELAXED, __ATOMIC_RELAXED, __HIP_MEMORY_SCOPE_AGENT);
                                     __hip_atomic_store(tmo, 1u, __ATOMIC_RELAXED, __HIP_MEMORY_SCOPE_AGENT); }
                    dead = true; break; }
                __builtin_amdgcn_s_sleep(2);
            }
            __builtin_amdgcn_fence(__ATOMIC_ACQUIRE, "agent");
            if (lane == 0) flag[0] = dead ? 1u : 0u;
        }
        asm volatile("s_waitcnt vmcnt(0) lgkmcnt(0)" ::: "memory"); __builtin_amdgcn_s_barrier(); asm volatile("" ::: "memory");
        const bool bad = flag[0] != 0u;
        if (lane < 32) {
            const unsigned long long* slot = (const unsigned long long*)xbuf + (size_t)(u.pm * BM + row) * 4; float mt[4], m2[4]; float ms = 0.f;
#pragma unroll
            for (int t = 0; t < 4; ++t) { if (t < ntn) { const unsigned long long w = __hip_atomic_load(slot + t, __ATOMIC_RELAXED, __HIP_MEMORY_SCOPE_AGENT); mt[t] = __uint_as_float((unsigned)w); m2[t] = __uint_as_float((unsigned)(w >> 32)); } else { mt[t] = 0.f; m2[t] = 0.f; } ms += mt[t]; }
            const float mean = ms / (float)ntn; float q = 0.f;
#pragma unroll
            for (int t = 0; t < 4; ++t) if (t < ntn) { const float dm = mt[t] - mean; q += m2[t] + 256.0f * dm * dm; }
            S[row] = (f32x2v){mean, 1.0f / sqrtf(q / (256.0f * (float)ntn) + eps)};
        }
        asm volatile("s_waitcnt lgkmcnt(0)" ::: "memory"); __builtin_amdgcn_s_barrier(); asm volatile("" ::: "memory");
        return bad;
    }
};
struct EpiLnRes {
    static constexpr bool PERM = false, AFTER_DRAIN = true;
    const float* base; float* out; int ldc; const float* bias; PanelStats st; unsigned poison;
    __device__ __forceinline__ void fused(f32x4 (&acc)[2][2][4][2], const Unit& u, int wr, int wc, int fr, int fq, PG8_LAS unsigned char* lds, int wid, int lane) const {
        typedef float f32x2v __attribute__((ext_vector_type(2)));
        const PG8_LAS f32x2v* S = (const PG8_LAS f32x2v*)(lds + 8192);
        const int col0 = u.pn * BM + wc * 32 + 4 * fq;
#pragma unroll
        for (int bj = 0; bj < 2; ++bj)
#pragma unroll
            for (int n = 0; n < 2; ++n) { const f32x4 bv = bias ? *(const f32x4*)(bias + col0 + bj * HALF + n * 16) : (f32x4){0.f, 0.f, 0.f, 0.f};
#pragma unroll
                for (int ai = 0; ai < 2; ++ai)
#pragma unroll
                    for (int m = 0; m < 4; ++m) acc[ai][bj][m][n] += bv; }
        f32x4 pre[4][2][2];
#pragma unroll
        for (int m = 0; m < 4; ++m) { const size_t off = (size_t)(u.pm * BM + wr * 64 + m * 16 + fr) * ldc + col0;
#pragma unroll
            for (int bj = 0; bj < 2; ++bj)
#pragma unroll
                for (int n = 0; n < 2; ++n) pre[m][bj][n] = *(const f32x4*)(base + off + bj * HALF + n * 16); }
        const bool bad = st.run(acc, u, wr, wc, fr, fq, lds, wid, lane) || poison != 0u;
        const float qnan = __builtin_nanf("");
#pragma unroll
        for (int ai = 0; ai < 2; ++ai)
#pragma unroll
            for (int m = 0; m < 4; ++m) { const int r = ai * HALF + wr * 64 + m * 16 + fr; const f32x2v sr = S[r]; const size_t off = (size_t)(u.pm * BM + r) * ldc + col0;
#pragma unroll
                for (int bj = 0; bj < 2; ++bj)
#pragma unroll
                    for (int n = 0; n < 2; ++n) { const f32x4 bs = ai == 0 ? pre[m][bj][n] : *(const f32x4*)(base + off + bj * HALF + n * 16); f32x4 o = bs + (acc[ai][bj][m][n] - sr.x) * sr.y;
                        if (bad) o = (f32x4){qnan, qnan, qnan, qnan}; *(f32x4*)(out + off + bj * HALF + n * 16) = o; }
                if (m & 1) asm volatile("" ::: "memory"); }
    }
};
struct EpiLnResLn {
    static constexpr bool PERM = false, AFTER_DRAIN = true;
    const float* base; float* out; bf16_t* xn; int ldc; const float* bias; PanelStats st1, st2; unsigned poison;
    __device__ __forceinline__ void fused(f32x4 (&acc)[2][2][4][2], const Unit& u, int wr, int wc, int fr, int fq, PG8_LAS unsigned char* lds, int wid, int lane) const {
        typedef float f32x2v __attribute__((ext_vector_type(2))); typedef unsigned u32x2v __attribute__((ext_vector_type(2)));
        const PG8_LAS f32x2v* S = (const PG8_LAS f32x2v*)(lds + 8192);
        const int col0 = u.pn * BM + wc * 32 + 4 * fq;
#pragma unroll
        for (int bj = 0; bj < 2; ++bj)
#pragma unroll
            for (int n = 0; n < 2; ++n) { const f32x4 bv = bias ? *(const f32x4*)(bias + col0 + bj * HALF + n * 16) : (f32x4){0.f, 0.f, 0.f, 0.f};
#pragma unroll
                for (int ai = 0; ai < 2; ++ai)
#pragma unroll
                    for (int m = 0; m < 4; ++m) acc[ai][bj][m][n] += bv; }
        bool bad = st1.run(acc, u, wr, wc, fr, fq, lds, wid, lane) || poison != 0u;
        const float qnan = __builtin_nanf("");
#pragma unroll
        for (int ai = 0; ai < 2; ++ai)
#pragma unroll
            for (int m = 0; m < 4; ++m) { const int r = ai * HALF + wr * 64 + m * 16 + fr; const f32x2v sr = S[r]; const size_t off = (size_t)(u.pm * BM + r) * ldc + col0;
#pragma unroll
                for (int bj = 0; bj < 2; ++bj)
#pragma unroll
                    for (int n = 0; n < 2; ++n) { const f32x4 bs = *(const f32x4*)(base + off + bj * HALF + n * 16); acc[ai][bj][m][n] = bs + (acc[ai][bj][m][n] - sr.x) * sr.y; }
                asm volatile("" : "+v"(acc[ai][0][m][0]), "+v"(acc[ai][0][m][1]), "+v"(acc[ai][1][m][0]), "+v"(acc[ai][1][m][1]));
                if (m & 1) asm volatile("" ::: "memory"); }
        const bool bad1 = bad;
        bad = st2.run(acc, u, wr, wc, fr, fq, lds, wid, lane) || bad;
#pragma unroll
        for (int ai = 0; ai < 2; ++ai)
#pragma unroll
            for (int m = 0; m < 4; ++m) { const int r = ai * HALF + wr * 64 + m * 16 + fr; const f32x2v sr = S[r]; const size_t off = (size_t)(u.pm * BM + r) * ldc + col0;
#pragma unroll
                for (int bj = 0; bj < 2; ++bj)
#pragma unroll
                    for (int n = 0; n < 2; ++n) { const f32x4 x1 = acc[ai][bj][m][n]; *(f32x4*)(out + off + bj * HALF + n * 16) = bad1 ? (f32x4){qnan, qnan, qnan, qnan} : x1;
                        const f32x4 o = (x1 - sr.x) * sr.y; u32x2v w; w.x = cvt_pk_bf16(o[0], o[1]); w.y = cvt_pk_bf16(o[2], o[3]);
                        if (bad) { w.x = 0x7fc07fc0u; w.y = 0x7fc07fc0u; } *(u32x2v*)(xn + off + bj * HALF + n * 16) = w; }
                asm volatile("" ::: "memory"); }
    }
};

template <class Epi, class Sched, bool ALIGN_EPI = false, bool SP2 = false>
__device__ __forceinline__ void gemm_phase(PG8_LAS unsigned char* lds, const Gemm g, const Sched& S, const Epi& E, const int tid) {
    const int wid = __builtin_amdgcn_readfirstlane(tid >> 6), lane = tid & 63, wr = wid >> 2, wc = wid & 3, fr = lane & 15, fq = lane >> 4;
    const int K = g.K, nt = K / BK;
    unsigned voffA[2], voffB[2];
#pragma unroll
    for (int i = 0; i < 2; ++i) { int R, C; stage_rc(tid * 16 + i * 8192, R, C); const int Rb = Epi::PERM ? ((R & ~31) + perm32(R & 31)) : R;
        voffA[i] = (unsigned)(R * K + C) * 2u; voffB[i] = (unsigned)(Rb * K + C) * 2u; }
    const size_t kstep = (size_t)(BK * 2);
    const size_t hstep = (size_t)HALF * K * 2;
    const size_t tstep = 2 * hstep;
    const unsigned ldsw = (unsigned)wid * 1024u;
    const int aoff = lds_byte(wr * 64 + fr, fq * 8), boff = lds_byte(wc * 32 + fr, fq * 8);
#define PG8_SA(b, h) (((b) * 2 + (h)) * HTB)
#define PG8_SB(b, h) ((4 + (b) * 2 + (h)) * HTB)
#define PG8_STAGE(bufoff, gbase, voff) do { _Pragma("unroll") for (int _i = 0; _i < 2; ++_i) \
        __builtin_amdgcn_global_load_lds((const unsigned*)((const char*)(gbase) + (voff)[_i]), (PG8_LAS unsigned*)(lds + (bufoff) + ldsw + _i * 8192), 16, 0, 0); } while (0)
#define PG8_LDA(dst, b, h) do { _Pragma("unroll") for (int m = 0; m < 4; ++m) _Pragma("unroll") for (int k = 0; k < 2; ++k) dst[m][k] = *(const PG8_LAS bf16x8*)(lds + PG8_SA(b, h) + aoff + m * 2048 + k * 1024); } while (0)
#define PG8_LDB(dst, b, h) do { _Pragma("unroll") for (int n = 0; n < 2; ++n) _Pragma("unroll") for (int k = 0; k < 2; ++k) dst[n][k] = *(const PG8_LAS bf16x8*)(lds + PG8_SB(b, h) + boff + n * 2048 + k * 1024); } while (0)
#define PG8_MMA(ai, bj, At, Bt) do { __builtin_amdgcn_s_setprio(1); _Pragma("unroll") for (int m = 0; m < 4; ++m) _Pragma("unroll") for (int n = 0; n < 2; ++n) _Pragma("unroll") for (int k = 0; k < 2; ++k) \
        acc[ai][bj][m][n] = __builtin_amdgcn_mfma_f32_16x16x32_bf16(Bt[n][k], At[m][k], acc[ai][bj][m][n], 0, 0, 0); __builtin_amdgcn_s_setprio(0); } while (0)
#define PG8_WAIT_V(n) asm volatile("s_waitcnt vmcnt(" #n ")" ::: "memory")
#define PG8_WAIT_L(n) asm volatile("s_waitcnt lgkmcnt(" #n ")" ::: "memory")
#define PG8_BAR __builtin_amdgcn_s_barrier()
#define PG8_SCHED __builtin_amdgcn_sched_barrier(0)
    Unit cur, nxt; int ui = 0;
    if (!S.next(0, cur)) return;
    f32x4 acc[2][2][4][2];
#pragma unroll
    for (int a = 0; a < 2; ++a)
#pragma unroll
        for (int b = 0; b < 2; ++b)
#pragma unroll
            for (int m = 0; m < 4; ++m)
#pragma unroll
                for (int n = 0; n < 2; ++n) acc[a][b][m][n] = (f32x4){0.f, 0.f, 0.f, 0.f};
    bf16x8 At[4][2], B0[2][2], B1[2][2];
    const char* cA = (const char*)g.A + (size_t)cur.pm * tstep; const char* cB = (const char*)g.Bt + (size_t)cur.pn * tstep;
    S.a_ready(cur);
    if constexpr (SP2) {
        PG8_STAGE(PG8_SB(0, 0), cB, voffB); PG8_STAGE(PG8_SB(0, 1), cB + hstep, voffB); PG8_STAGE(PG8_SA(0, 0), cA, voffA); PG8_STAGE(PG8_SA(0, 1), cA + hstep, voffA);
        if (wr == 1) PG8_BAR;
        PG8_WAIT_V(2); PG8_BAR;
        PG8_STAGE(PG8_SB(1, 0), cB + kstep, voffB); PG8_STAGE(PG8_SA(1, 0), cA + kstep, voffA); PG8_STAGE(PG8_SB(1, 1), cB + hstep + kstep, voffB);
        PG8_WAIT_V(6); PG8_BAR;
    } else {
        PG8_STAGE(PG8_SB(0, 0), cB, voffB); PG8_STAGE(PG8_SA(0, 0), cA, voffA); PG8_STAGE(PG8_SB(0, 1), cB + hstep, voffB); PG8_STAGE(PG8_SA(0, 1), cA + hstep, voffA);
        if (wr == 1) PG8_BAR;
        PG8_WAIT_V(4); PG8_BAR;
        PG8_STAGE(PG8_SB(1, 0), cB + kstep, voffB); PG8_STAGE(PG8_SA(1, 0), cA + kstep, voffA); PG8_STAGE(PG8_SB(1, 1), cB + hstep + kstep, voffB);
        PG8_WAIT_V(6); PG8_BAR;
    }
    for (;;) {
        const bool has_next = S.next(ui + 1, nxt);
        const char* nA = has_next ? (const char*)g.A + (size_t)nxt.pm * tstep : cA; const char* nB = has_next ? (const char*)g.Bt + (size_t)nxt.pn * tstep : cB;
        for (int t = 0; t < nt; t += 2) {
            const bool last = (t == nt - 2);
            const char* a1 = cA + (size_t)(t + 1) * kstep;
            const char* a2 = last ? nA : cA + (size_t)(t + 2) * kstep; const char* b2 = last ? nB : cB + (size_t)(t + 2) * kstep;
            const char* a3 = a2 + kstep; const char* b3 = b2 + kstep;
            if (last && has_next) S.a_ready(nxt);
            if constexpr (SP2) {
            PG8_LDB(B0, 0, 0); PG8_LDB(B1, 0, 1); PG8_SCHED; PG8_LDA(At, 0, 0); PG8_STAGE(PG8_SA(1, 1), a1 + hstep, voffA);
            PG8_WAIT_V(8); PG8_WAIT_L(0); PG8_BAR; PG8_MMA(0, 0, At, B0); PG8_MMA(0, 1, At, B1); PG8_BAR; PG8_SCHED;
            PG8_LDA(At, 0, 1); PG8_STAGE(PG8_SB(0, 0), b2, voffB); PG8_STAGE(PG8_SB(0, 1), b2 + hstep, voffB); PG8_STAGE(PG8_SA(0, 0), a2, voffA);
            PG8_WAIT_V(8); PG8_WAIT_L(0); PG8_BAR; PG8_MMA(1, 0, At, B0); PG8_MMA(1, 1, At, B1); PG8_BAR; PG8_SCHED;
            PG8_LDB(B0, 1, 0); PG8_LDB(B1, 1, 1); PG8_SCHED; PG8_LDA(At, 1, 0); PG8_STAGE(PG8_SA(0, 1), a2 + hstep, voffA);
            PG8_WAIT_V(8); PG8_WAIT_L(0); PG8_BAR; PG8_MMA(0, 0, At, B0); PG8_MMA(0, 1, At, B1); PG8_BAR; PG8_SCHED;
            PG8_LDA(At, 1, 1); PG8_STAGE(PG8_SB(1, 0), b3, voffB); PG8_STAGE(PG8_SB(1, 1), b3 + hstep, voffB); PG8_STAGE(PG8_SA(1, 0), a3, voffA);
            PG8_WAIT_V(8); PG8_WAIT_L(0); PG8_BAR; PG8_MMA(1, 0, At, B0); PG8_MMA(1, 1, At, B1); PG8_BAR; PG8_SCHED;
            } else {
            PG8_LDB(B0, 0, 0); PG8_SCHED; PG8_LDA(At, 0, 0); PG8_STAGE(PG8_SA(1, 1), a1 + hstep, voffA);
            PG8_WAIT_L(8); PG8_BAR; PG8_WAIT_L(0); PG8_MMA(0, 0, At, B0); PG8_BAR; PG8_SCHED;
            PG8_LDB(B1, 0, 1); PG8_STAGE(PG8_SB(0, 0), b2, voffB);
            PG8_BAR; PG8_WAIT_L(0); PG8_MMA(0, 1, At, B1); PG8_BAR;
            PG8_LDA(At, 0, 1); PG8_STAGE(PG8_SA(0, 0), a2, voffA);
            PG8_BAR; PG8_WAIT_L(0); PG8_MMA(1, 0, At, B0); PG8_BAR; PG8_SCHED;
            PG8_STAGE(PG8_SB(0, 1), b2 + hstep, voffB);
            PG8_WAIT_V(6); PG8_BAR; PG8_MMA(1, 1, At, B1); PG8_BAR;
            PG8_LDB(B0, 1, 0); PG8_SCHED; PG8_LDA(At, 1, 0); PG8_STAGE(PG8_SA(0, 1), a2 + hstep, voffA);
            PG8_WAIT_L(8); PG8_BAR; PG8_WAIT_L(0); PG8_MMA(0, 0, At, B0); PG8_BAR; PG8_SCHED;
            PG8_LDB(B1, 1, 1); PG8_STAGE(PG8_SB(1, 0), b3, voffB);
            PG8_BAR; PG8_WAIT_L(0); PG8_MMA(0, 1, At, B1); PG8_BAR;
            PG8_LDA(At, 1, 1); PG8_STAGE(PG8_SA(1, 0), a3, voffA);
            PG8_BAR; PG8_WAIT_L(0); PG8_MMA(1, 0, At, B0); PG8_BAR; PG8_SCHED;
            PG8_STAGE(PG8_SB(1, 1), b3 + hstep, voffB);
            PG8_WAIT_V(6); PG8_BAR; PG8_MMA(1, 1, At, B1); PG8_BAR;
            }
        }
        if constexpr (ALIGN_EPI) { if (wr == 0) PG8_BAR; }
        if constexpr (!Epi::AFTER_DRAIN) { E(acc, cur, wr, wc, fr, fq); S.done(cur); }
        if (!has_next) break;
#pragma unroll
        for (int a = 0; a < 2; ++a)
#pragma unroll
            for (int b = 0; b < 2; ++b)
#pragma unroll
                for (int m = 0; m < 4; ++m)
#pragma unroll
                    for (int n = 0; n < 2; ++n) acc[a][b][m][n] = (f32x4){0.f, 0.f, 0.f, 0.f};
        cur = nxt; cA = nA; cB = nB; ++ui;
        if constexpr (ALIGN_EPI) { if (wr == 1) PG8_BAR; }
    }
    PG8_WAIT_V(0);
    if constexpr (!ALIGN_EPI) { if (wr == 0) PG8_BAR; }
    PG8_BAR;
    if constexpr (Epi::AFTER_DRAIN) { E.fused(acc, cur, wr, wc, fr, fq, lds, wid, lane); S.done(cur); }
#undef PG8_SA
#undef PG8_SB
#undef PG8_STAGE
#undef PG8_LDA
#undef PG8_LDB
#undef PG8_MMA
#undef PG8_WAIT_V
#undef PG8_WAIT_L
#undef PG8_BAR
#undef PG8_SCHED
}
}

#ifndef PG8_SP2
#define PG8_SP2 true
#endif
#ifndef PG8_ALIGN
#define PG8_ALIGN true
#endif

#define GAS __attribute__((address_space(1)))
#define LAS __attribute__((address_space(3)))
typedef unsigned short bf16;
typedef unsigned v4u __attribute__((ext_vector_type(4)));
typedef float f32x4 __attribute__((ext_vector_type(4)));
typedef short bf16x8 __attribute__((ext_vector_type(8)));
typedef GAS unsigned gu32;
typedef GAS unsigned long long gu64;
#define RLX_AGENT __ATOMIC_RELAXED, __HIP_MEMORY_SCOPE_AGENT
#define LDS_WAIT() asm volatile("s_waitcnt lgkmcnt(0)" ::: "memory")
#define VM_WAIT() asm volatile("s_waitcnt vmcnt(0)" ::: "memory")
__device__ __forceinline__ unsigned long long rt() { return __builtin_amdgcn_s_memrealtime(); }
__device__ __forceinline__ unsigned f2bf(float f) { unsigned u = __builtin_bit_cast(unsigned, f); return (u + 0x7fffu + ((u >> 16) & 1u)) >> 16; }
__device__ __forceinline__ unsigned pk2(float lo, float hi) { return f2bf(lo) | (f2bf(hi) << 16); }

#define XB_TMO      128
#define XB_XCNT(j)  (256  + 64 * (j))
#define XB_XSUB(j)  (1280 + 64 * (j))
#define XB_XGEN(j)  (2304 + 64 * (j))
#define XB_TOP      3328
#define XB_TOPGEN   3392
#define XCD_BAR_WORDS 3456
#define XB_SPIN_CAP (1u << 18)

__device__ __forceinline__ unsigned xb_ld(unsigned* p)              { return __hip_atomic_load(p, __ATOMIC_RELAXED, __HIP_MEMORY_SCOPE_AGENT); }
__device__ __forceinline__ unsigned xb_add(unsigned* p, unsigned v) { return __hip_atomic_fetch_add(p, v, __ATOMIC_RELAXED, __HIP_MEMORY_SCOPE_AGENT); }
__device__ __forceinline__ unsigned xb_xcc_id() { return (unsigned)__builtin_amdgcn_s_getreg((3 << 11) | 20) & 0xFu; }
#define XB_SPIN(cond, bar) do { unsigned _sp = 0; while (cond) { __builtin_amdgcn_s_sleep(1); \
    if ((++_sp & 255u) == 0u) { if (xb_ld(&(bar)[XB_TMO])) break; if (_sp > XB_SPIN_CAP) { atomicAdd(&(bar)[XB_TMO], 1u); break; } } } } while (0)

struct XcdBarrier {
    unsigned* bar; unsigned x;
    volatile LAS unsigned* st;
};

__device__ __forceinline__ XcdBarrier xcd_barrier_post(unsigned* bar, volatile LAS unsigned* st) {
    XcdBarrier b; b.bar = bar; b.x = xb_xcc_id(); b.st = st;
    if (threadIdx.x == 0) (void)xb_add(&bar[XB_XCNT(b.x)], 1u);
    return b;
}
__device__ __forceinline__ void xcd_barrier_complete(unsigned* bar, unsigned x, unsigned& nloc, unsigned& nx) {
    const unsigned G = gridDim.x * gridDim.y * gridDim.z;
    unsigned sum, cnt, mine, sp = 0u;
    for (;;) {
        sum = 0u; cnt = 0u; mine = 0u;
#pragma unroll
        for (unsigned j = 0; j < 16; ++j) { const unsigned c = xb_ld(&bar[XB_XCNT(j)]); sum += c; cnt += (c > 0u) ? 1u : 0u; mine = (j == x) ? c : mine; }
        if (sum == G) break;
        __builtin_amdgcn_s_sleep(1);
        if ((++sp & 255u) == 0u) { if (xb_ld(&bar[XB_TMO])) break; if (sp > XB_SPIN_CAP) { atomicAdd(&bar[XB_TMO], 1u); break; } }
    }
    nloc = mine > 0u ? mine : 1u; nx = cnt > 0u ? cnt : 1u;
}

__device__ __forceinline__ void xcd_barrier(const XcdBarrier& b) {
    asm volatile("s_waitcnt vmcnt(0)" ::: "memory");
    __syncthreads();
    if (threadIdx.x == 0) {
        unsigned* bar = b.bar;
        __builtin_amdgcn_s_waitcnt(0);
        unsigned nloc = b.st[0], nx = b.st[1];
        if (nloc == 0u) { xcd_barrier_complete(bar, b.x, nloc, nx); b.st[0] = nloc; b.st[1] = nx; }
        const unsigned old = xb_add(&bar[XB_XSUB(b.x)], 1u);
        const unsigned gen = old / nloc;
        if (old + 1u == (gen + 1u) * nloc) {
            __builtin_amdgcn_fence(__ATOMIC_RELEASE, "agent");
            asm volatile("s_waitcnt vmcnt(0)" ::: "memory");
            const unsigned og = xb_add(&bar[XB_TOP], 1u);
            const unsigned tg = og / nx;
            if (og + 1u == (tg + 1u) * nx) xb_add(&bar[XB_TOPGEN], 1u);
            else XB_SPIN(xb_ld(&bar[XB_TOPGEN]) == tg, bar);
            __builtin_amdgcn_fence(__ATOMIC_ACQUIRE, "agent");
            xb_add(&bar[XB_XGEN(b.x)], 1u);
            asm volatile("s_waitcnt vmcnt(0)" ::: "memory");
        } else {
            XB_SPIN(xb_ld(&bar[XB_XGEN(b.x)]) == gen, bar);
            __builtin_amdgcn_fence(__ATOMIC_ACQUIRE, "agent");
            asm volatile("s_waitcnt vmcnt(0)" ::: "memory");
        }
    }
    __syncthreads();
}

namespace pg8 {
struct EpiF32 {
    static constexpr bool PERM = false, AFTER_DRAIN = false;
    float* O; int ldc;
    __device__ __forceinline__ void operator()(const f32x4 (&acc)[2][2][4][2], const Unit& u, int wr, int wc, int fr, int fq) const {
        const int row0 = u.pm * BM + wr * 64 + fr, col0 = u.pn * BM + wc * 32 + 4 * fq;
#pragma unroll
        for (int ai = 0; ai < 2; ++ai)
#pragma unroll
            for (int m = 0; m < 4; ++m) { float* rowp = O + (size_t)(row0 + ai * HALF + m * 16) * ldc + col0;
#pragma unroll
                for (int bj = 0; bj < 2; ++bj)
#pragma unroll
                    for (int n = 0; n < 2; ++n) *(f32x4*)(rowp + bj * HALF + n * 16) = acc[ai][bj][m][n]; }
    }
};
__device__ __forceinline__ float silu_f(float x) { return x / (1.0f + __expf(-x)); }
struct EpiSwiGLU {
    static constexpr bool PERM = true, AFTER_DRAIN = false;
    bf16_t* O; int ldc;
    __device__ __forceinline__ void operator()(const f32x4 (&acc)[2][2][4][2], const Unit& u, int wr, int wc, int fr, int fq) const {
        const int row0 = u.pm * BM + wr * 64 + fr, col0 = u.pn * HALF + wc * 32 + 8 * fq;
#pragma unroll
        for (int ai = 0; ai < 2; ++ai)
#pragma unroll
            for (int m = 0; m < 4; ++m) { bf16_t* rowp = O + (size_t)(row0 + ai * HALF + m * 16) * ldc + col0;
                const f32x4 a0 = acc[ai][0][m][0], a1 = acc[ai][0][m][1], b0 = acc[ai][1][m][0], b1 = acc[ai][1][m][1];
                u32x4 w; w.x = cvt_pk_bf16(silu_f(a0[0]) * b0[0], silu_f(a0[1]) * b0[1]); w.y = cvt_pk_bf16(silu_f(a0[2]) * b0[2], silu_f(a0[3]) * b0[3]);
                w.z = cvt_pk_bf16(silu_f(a1[0]) * b1[0], silu_f(a1[1]) * b1[1]); w.w = cvt_pk_bf16(silu_f(a1[2]) * b1[2], silu_f(a1[3]) * b1[3]);
                *(u32x4*)rowp = w; }
    }
};
}

constexpr int NWAVES = 8;
constexpr int NTHREADS = NWAVES * 64;
#ifndef MK_PER_PHASE
#define MK_PER_PHASE 0
#endif
constexpr int D = 1024, NCTX = 8192, NSMP = 2048, M = NCTX + NSMP, DEPTH = 2;
constexpr int LC = 256, LS = 1024, NB_C = 32, NB_S = 2, GRIDW = 64;
constexpr int INC = 2848, INP = 3072, FF = 2816;
constexpr int OA = 0, OBc = 768, OCc = 1568, ODc = 2080;
constexpr float EPS = 1e-6f;
constexpr int NPHASE = 2 + 8 * DEPTH;

constexpr size_t MiB = 1u << 20;
constexpr size_t WS_CTL = 0, CTL_ZERO_BYTES = 1 * MiB;
constexpr size_t WS_MOD = 1 * MiB;
constexpr size_t WS_FILT = 2 * MiB;
constexpr size_t FILT_LAYER = 5 * MiB, FILT_S_OFF = 1 * MiB;
constexpr size_t WS_W = 12 * MiB, W_LAYER = 25 * MiB;
constexpr size_t W_IN = 0, W_OUT = 6 * MiB, W_13 = 8 * MiB, W_2 = 19 * MiB;
constexpr size_t WS_H = 62 * MiB;
constexpr size_t WS_P = 82 * MiB;
constexpr size_t WS_MIX = 142 * MiB;
constexpr size_t WS_MF = 162 * MiB;
constexpr size_t WS_OF = 202 * MiB, WS_OB = 212 * MiB;
constexpr size_t WS_END = 222 * MiB;
constexpr int CW_TMO = 0, CW_CODE = 1, CW_BAR = 4096;

constexpr int RING_OFF = 0, RING_BYTES = 131072;
constexpr int LDSCTL_OFF = RING_BYTES, MISC_OFF = LDSCTL_OFF + 320;
constexpr int LDS_BYTES = 147456;

struct Args { const float* in[32]; float* out; unsigned char* ws; int ph_lo, ph_hi, li, pad; };

__device__ __forceinline__ float bf2f(bf16 b) { return __uint_as_float((unsigned)b << 16); }
__device__ __forceinline__ float gelu_tanh(float x) { const float u = 0.7978845608028654f * (x + 0.044715f * x * x * x); return 0.5f * x * (1.0f + tanhf(u)); }
__device__ __forceinline__ float silu_acc(float x) { return x / (1.0f + expf(-x)); }
__device__ __forceinline__ float logsigmoid_f(float x) { return fminf(x, 0.f) - log1pf(expf(-fabsf(x))); }
__device__ __forceinline__ float wave_sum(float v) {
#pragma unroll
    for (int o = 1; o < 64; o <<= 1) v += __shfl_xor(v, o);
    return v;
}

__device__ __forceinline__ void p0_transpose_item(const float* W, int K, int N, bf16* WT, int k0, int n0, int drow0, LAS float* scr, int lane) {
#pragma unroll 8
    for (int i = 0; i < 32; ++i) { const int kk = 2 * i + (lane >> 5); scr[kk * 33 + (lane & 31)] = W[(size_t)(k0 + kk) * N + n0 + (lane & 31)]; }
    LDS_WAIT(); asm volatile("" ::: "memory");
    const int c = lane & 7;
#pragma unroll
    for (int j = 0; j < 4; ++j) { const int n = (lane >> 3) + 8 * j; const LAS float* s = scr + (8 * c) * 33 + n;
        v4u o; o.x = pk2(s[0 * 33], s[1 * 33]); o.y = pk2(s[2 * 33], s[3 * 33]); o.z = pk2(s[4 * 33], s[5 * 33]); o.w = pk2(s[6 * 33], s[7 * 33]);
        *(GAS v4u*)(WT + (size_t)(drow0 + n) * K + k0 + 8 * c) = o; }
    LDS_WAIT(); asm volatile("" ::: "memory");
}

__device__ __forceinline__ void p0_filter_item(const Args& a, int l, int path, int pb, LAS float* scr, int lane) {
    const int L = path ? LS : LC;
    float* T = (float*)(a.ws + WS_FILT + (size_t)l * FILT_LAYER + (path ? FILT_S_OFF : 0));
    const float* w1 = a.in[20] + (size_t)l * 17 * 64; const float* b1 = a.in[21] + l * 64; const float* fr = a.in[22] + l * 64;
    const float* w2 = a.in[23] + (size_t)l * 64 * 64; const float* b2 = a.in[24] + l * 64; const float* w3 = a.in[25] + (size_t)l * 64 * 1024;
    const float* ld = a.in[26] + (size_t)l * 1024; const float* hb = a.in[27] + (size_t)l * 512;
    LAS float* feat = scr;
    LAS float* h1 = scr + 160;
    LAS float* h2 = scr + 160 + 512;
    const float TWO_PI = 6.283185307179586f;
    if (lane < 17) {
#pragma unroll
        for (int p = 0; p < 8; ++p) { const int pos = pb * 8 + p; const float t = (float)pos / (float)(L - 1); const float om = TWO_PI * (float)pos / (float)L;
            float v;
            if (lane == 0) v = t;
            else { const int bi = (lane - 1) & 7; const float band = 1e-4f + (float)bi * ((7.0f - 1e-4f) / 7.0f); v = (lane <= 8) ? cosf(om * band) : sinf(om * band); }
            feat[p * 20 + lane] = v; }
    }
    LDS_WAIT(); asm volatile("" ::: "memory");
    const float frq = fr[lane];
    {   float acc[8];
#pragma unroll
        for (int p = 0; p < 8; ++p) acc[p] = b1[lane];
        for (int f = 0; f < 17; ++f) { const float w = w1[f * 64 + lane];
#pragma unroll
            for (int p = 0; p < 8; ++p) acc[p] += feat[p * 20 + f] * w; }
#pragma unroll
        for (int p = 0; p < 8; ++p) h1[p * 64 + lane] = sinf(frq * acc[p]);
    }
    LDS_WAIT(); asm volatile("" ::: "memory");
    {   float acc[8];
#pragma unroll
        for (int p = 0; p < 8; ++p) acc[p] = b2[lane];
        for (int i = 0; i < 64; ++i) { const float w = w2[i * 64 + lane];
#pragma unroll
            for (int p = 0; p < 8; ++p) acc[p] += h1[p * 64 + i] * w; }
#pragma unroll
        for (int p = 0; p < 8; ++p) h2[p * 64 + lane] = sinf(frq * acc[p]);
    }
    LDS_WAIT(); asm volatile("" ::: "memory");
#pragma unroll
    for (int q = 0; q < 4; ++q) {
        f32x4 acc[8];
#pragma unroll
        for (int p = 0; p < 8; ++p) acc[p] = (f32x4){0.f, 0.f, 0.f, 0.f};
        for (int i = 0; i < 64; ++i) { const f32x4 w = *(const f32x4*)(w3 + (size_t)i * 1024 + q * 256 + 4 * lane);
#pragma unroll
            for (int p = 0; p < 8; ++p) acc[p] += w * h2[p * 64 + i]; }
        const int dir = q >> 1, o = q & 1;
        const f32x4 ldv = *(const f32x4*)(ld + q * 256 + 4 * lane);
        const f32x4 bv = *(const f32x4*)(hb + o * 256 + 4 * lane);
        f32x4 rate; rate[0] = expf(ldv[0]); rate[1] = expf(ldv[1]); rate[2] = expf(ldv[2]); rate[3] = expf(ldv[3]);
#pragma unroll
        for (int p = 0; p < 8; ++p) { const int pos = pb * 8 + p; const float t = (float)pos / (float)(L - 1);
            f32x4 v; v[0] = acc[p][0] * expf(-rate[0] * t); v[1] = acc[p][1] * expf(-rate[1] * t); v[2] = acc[p][2] * expf(-rate[2] * t); v[3] = acc[p][3] * expf(-rate[3] * t);
            float* dst;
            if (dir == 0) { if (pos == 0) v += bv; dst = T + ((size_t)o * 2 * L + (L + pos)) * 256 + 4 * lane; *(f32x4*)dst = v; }
            else { if (pos == 0) v = (f32x4){0.f, 0.f, 0.f, 0.f}; dst = T + ((size_t)o * 2 * L + (L - pos)) * 256 + 4 * lane; if (pos == 0) dst = T + ((size_t)o * 2 * L) * 256 + 4 * lane; *(f32x4*)dst = v; }
        }
    }
    LDS_WAIT(); asm volatile("" ::: "memory");
}

__device__ __forceinline__ void p0_mod_item(const Args& a, int l, int cb, LAS float* sv  , LAS float* red  , int wave, int lane, int tid) {
    const float* wm = a.in[5] + (size_t)l * D * 6144; const float* bm = a.in[6] + (size_t)l * 6144;
    float* mod = (float*)(a.ws + WS_MOD) + (size_t)l * 3 * 6144;
    const int j0 = cb * 64 + 4 * (lane & 15), ks = lane >> 4;
    f32x4 acc[3];
#pragma unroll
    for (int c = 0; c < 3; ++c) acc[c] = (f32x4){0.f, 0.f, 0.f, 0.f};
#pragma unroll 8
    for (int i = 0; i < 32; ++i) { const int k = wave * 128 + i * 4 + ks; const f32x4 w = *(const f32x4*)(wm + (size_t)k * 6144 + j0);
#pragma unroll
        for (int c = 0; c < 3; ++c) acc[c] += w * sv[c * 1024 + k]; }
#pragma unroll
    for (int c = 0; c < 3; ++c)
#pragma unroll
        for (int e = 0; e < 4; ++e) { float v = acc[c][e]; v += __shfl_xor(v, 16); v += __shfl_xor(v, 32); acc[c][e] = v; }
    if (lane < 16) {
#pragma unroll
        for (int c = 0; c < 3; ++c)
#pragma unroll
            for (int e = 0; e < 4; ++e) red[(wave * 3 + c) * 64 + 4 * lane + e] = acc[c][e];
    }
    __syncthreads();
    if (tid < 192) { const int c = tid >> 6, j = tid & 63; float s = bm[cb * 64 + j];
#pragma unroll
        for (int w = 0; w < 8; ++w) s += red[(w * 3 + c) * 64 + j];
        mod[c * 6144 + cb * 64 + j] = s; }
    __syncthreads();
}

__device__ __forceinline__ void p0_prologue(const Args& a, LAS unsigned char* lds, int vcu, int G, int wave, int lane, int tid) {
    LAS float* scr = (LAS float*)(lds + RING_OFF + wave * 16384);
    {
        LAS float* sv = (LAS float*)(lds + RING_OFF);
        LAS float* red = (LAS float*)(lds + RING_OFF + 12288);
        bool any = false;
        for (int it = vcu; it < DEPTH * 96; it += G) {
            if (!any) {
                for (int i = tid; i < 3 * 1024; i += NTHREADS) { const int c = i >> 10, k = i & 1023; const float v = (c == 0) ? a.in[4][k] : a.in[3][(c - 1) * 1024 + k]; sv[i] = silu_acc(v); }
                __syncthreads(); any = true;
            }
            p0_mod_item(a, it / 96, it % 96, sv, red, wave, lane, tid);
        }
        __syncthreads();
    }
    const int gw = vcu * NWAVES + wave, NGW = G * NWAVES;
    for (int it = gw; it < DEPTH * 160; it += NGW) { const int l = it / 160, r = it % 160; if (r < 128) p0_filter_item(a, l, 1, r, scr, lane); else p0_filter_item(a, l, 0, r - 128, scr, lane); }
    constexpr int I_IN = 16 * 89, I_OUT = 16 * 32, I_1 = 16 * 88, I_2 = 44 * 32, I_PAD = 224;
    constexpr int I_LAYER = I_IN + I_OUT + 2 * I_1 + I_2 + I_PAD;
    for (int it = gw; it < DEPTH * I_LAYER; it += NGW) {
        const int l = it / I_LAYER; int r = it % I_LAYER;
        unsigned char* wl = a.ws + WS_W + (size_t)l * W_LAYER;
        if (r < I_IN) { const int kb = r / 89, nb = r % 89; p0_transpose_item(a.in[11] + (size_t)l * D * INC, D, INC, (bf16*)(wl + W_IN), 64 * kb, 32 * nb, 32 * nb, scr, lane); continue; } r -= I_IN;
        if (r < I_OUT) { const int kb = r / 32, nb = r % 32; p0_transpose_item(a.in[28] + (size_t)l * D * D, D, D, (bf16*)(wl + W_OUT), 64 * kb, 32 * nb, 32 * nb, scr, lane); continue; } r -= I_OUT;
        if (r < I_1) { const int kb = r / 88, nb = r % 88, n0 = 32 * nb; p0_transpose_item(a.in[29] + (size_t)l * D * FF, D, FF, (bf16*)(wl + W_13), 64 * kb, n0, (n0 >> 7) * 256 + (n0 & 127), scr, lane); continue; } r -= I_1;
        if (r < I_1) { const int kb = r / 88, nb = r % 88, n0 = 32 * nb; p0_transpose_item(a.in[30] + (size_t)l * D * FF, D, FF, (bf16*)(wl + W_13), 64 * kb, n0, (n0 >> 7) * 256 + 128 + (n0 & 127), scr, lane); continue; } r -= I_1;
        if (r < I_2) { const int kb = r / 32, nb = r % 32; p0_transpose_item(a.in[31] + (size_t)l * FF * D, FF, D, (bf16*)(wl + W_2), 64 * kb, 32 * nb, 32 * nb, scr, lane); continue; } r -= I_2;
        { GAS v4u* dst = (GAS v4u*)((bf16*)(wl + W_IN) + (size_t)(INC + r) * D) + lane * 2; dst[0] = (v4u){0u, 0u, 0u, 0u}; dst[1] = (v4u){0u, 0u, 0u, 0u}; }
    }
}

__device__ __forceinline__ void row_phase(const Args& a, int l, int mode, int vcu, int G, int wave, int lane) {
    const int gw = vcu * NWAVES + wave, NGW = G * NWAVES;
    const float* MF = (const float*)(a.ws + WS_MF); bf16* H = (bf16*)(a.ws + WS_H);
    const float* modb = (const float*)(a.ws + WS_MOD);
    const bool has_h = !(mode == 2 && l == DEPTH - 1);
    const int lh = (mode == 2) ? l + 1 : l;
    const float* gpre = (mode == 1) ? a.in[9] + lh * D : a.in[7] + (has_h ? lh : 0) * D;
    const float* gpost = (mode == 1) ? a.in[8] + l * D : a.in[10] + l * D;
    for (int r = gw; r < M; r += NGW) {
        const int cv = (r < NCTX) ? 0 : 1 + ((r - NCTX) >> 10);
        const float* xp = (mode == 0 || (mode == 1 && l == 0)) ? ((r < NCTX) ? a.in[0] + (size_t)r * D : a.in[1] + (size_t)(r - NCTX) * D) : a.out + (size_t)r * D;
        f32x4 x[4];
#pragma unroll
        for (int j = 0; j < 4; ++j) x[j] = *((const GAS f32x4*)xp + lane + 64 * j);
        if (mode != 0) {
            const float* mrow = MF + (size_t)r * D; f32x4 mv[4]; float s = 0.f;
#pragma unroll
            for (int j = 0; j < 4; ++j) { mv[j] = *((const GAS f32x4*)mrow + lane + 64 * j); s += (mv[j][0] * mv[j][0] + mv[j][1] * mv[j][1]) + (mv[j][2] * mv[j][2] + mv[j][3] * mv[j][3]); }
            const float rn = 1.0f / sqrtf(wave_sum(s) * (1.0f / D) + EPS);
            const float* gate = modb + ((size_t)l * 3 + cv) * 6144 + ((mode == 1) ? 2 : 5) * 1024;
#pragma unroll
            for (int j = 0; j < 4; ++j) { const f32x4 gt = *((const f32x4*)gate + lane + 64 * j), gp = *((const f32x4*)gpost + lane + 64 * j); x[j] = x[j] + gt * (mv[j] * rn * gp); }
#pragma unroll
            for (int j = 0; j < 4; ++j) *((GAS f32x4*)(a.out + (size_t)r * D) + lane + 64 * j) = x[j];
        }
        if (has_h) {
            float s = 0.f;
#pragma unroll
            for (int j = 0; j < 4; ++j) s += (x[j][0] * x[j][0] + x[j][1] * x[j][1]) + (x[j][2] * x[j][2] + x[j][3] * x[j][3]);
            const float rn = 1.0f / sqrtf(wave_sum(s) * (1.0f / D) + EPS);
            const float* mb = modb + ((size_t)lh * 3 + cv) * 6144 + ((mode == 1) ? 3 : 0) * 1024;
            GAS unsigned long long* o8 = (GAS unsigned long long*)(H + (size_t)r * D) + lane;
#pragma unroll
            for (int j = 0; j < 4; ++j) { const f32x4 sh = *((const f32x4*)mb + lane + 64 * j), sc = *((const f32x4*)(mb + 1024) + lane + 64 * j), gp = *((const f32x4*)gpre + lane + 64 * j);
                const f32x4 h = (x[j] * rn * gp) * (sc + 1.0f) + sh;
                o8[64 * j] = (unsigned long long)pk2(h[0], h[1]) | ((unsigned long long)pk2(h[2], h[3]) << 32); }
        }
    }
}

__device__ __forceinline__ int ba_row0(int ba) { return ba < 2 ? NCTX + ba * LS : (ba - 2) * LC; }

__device__ __forceinline__ void gla_wave_unit(const Args& a, int l, int ba, int h, int dir, LAS float* scr, int lane) {
    const int L = ba < 2 ? LS : LC, row0 = ba_row0(ba);
    const bf16* P = (const bf16*)(a.ws + WS_P);
    float* O = (float*)(a.ws + (dir ? WS_OB : WS_OF));
    float S[32];
    if (ba < 2) { const float* s0 = a.in[2] + ((((size_t)ba * DEPTH + l) * 2 + dir) * 4 + h) * 2048;
#pragma unroll
        for (int k = 0; k < 32; ++k) S[k] = s0[k * 64 + lane]; }
    else {
#pragma unroll
        for (int k = 0; k < 32; ++k) S[k] = 0.f; }
    const int kk = lane & 31;
    float wcol[16];
#pragma unroll
    for (int r = 0; r < 16; ++r) wcol[r] = a.in[13][(((size_t)l * 2 + dir) * 16 + r) * 128 + h * 32 + kk];
    const float bias = a.in[14][((size_t)l * 2 + dir) * 128 + h * 32 + kk];
    LAS float* qs = scr; LAS float* ks = scr + 512; LAS float* ds = scr + 1024;
    const float qscale = 0.17677669529663687f;
    for (int blk = 0; blk < L / 16; ++blk) {
        float vreg[16];
#pragma unroll
        for (int tt = 0; tt < 16; ++tt) { const int t = blk * 16 + tt, tau = dir ? L - 1 - t : t; vreg[tt] = bf2f(P[(size_t)(row0 + tau) * INP + OBc + 256 + h * 64 + lane]); }
#pragma unroll
        for (int i = 0; i < 8; ++i) { const int tt = (lane >> 5) + 2 * i, t = blk * 16 + tt, tau = dir ? L - 1 - t : t;
            const bf16* prow = P + (size_t)(row0 + tau) * INP + OBc;
            const float qv = bf2f(prow[h * 32 + kk]) * qscale, kv = bf2f(prow[128 + h * 32 + kk]);
            const bf16x8 g0 = *(const bf16x8*)(prow + 768 + dir * 16), g1 = *(const bf16x8*)(prow + 768 + dir * 16 + 8);
            float xx = bias;
#pragma unroll
            for (int r = 0; r < 8; ++r) { xx += bf2f((bf16)g0[r]) * wcol[r]; xx += bf2f((bf16)g1[r]) * wcol[8 + r]; }
            const float la = logsigmoid_f(xx) * (1.0f / 16.0f);
            qs[tt * 32 + kk] = qv; ks[tt * 32 + kk] = kv; ds[tt * 32 + kk] = expf(la); }
        LDS_WAIT(); asm volatile("" ::: "memory");
#pragma unroll 2
        for (int tt = 0; tt < 16; ++tt) { const int t = blk * 16 + tt, tau = dir ? L - 1 - t : t;
            float o = 0.f; const float v = vreg[tt];
#pragma unroll
            for (int k4 = 0; k4 < 8; ++k4) { const f32x4 q4 = *(const LAS f32x4*)(qs + tt * 32 + 4 * k4), k4v = *(const LAS f32x4*)(ks + tt * 32 + 4 * k4), d4 = *(const LAS f32x4*)(ds + tt * 32 + 4 * k4);
#pragma unroll
                for (int e = 0; e < 4; ++e) { S[4 * k4 + e] = d4[e] * S[4 * k4 + e] + k4v[e] * v; o += q4[e] * S[4 * k4 + e]; } }
            O[(size_t)(row0 + tau) * 256 + h * 64 + lane] = o; }
        LDS_WAIT(); asm volatile("" ::: "memory");
    }
    if (ba >= 2) { float* so = a.out + (size_t)M * D + ((((size_t)(ba - 2) * DEPTH + l) * 2 + dir) * 4 + h) * 2048;
#pragma unroll
        for (int k = 0; k < 32; ++k) so[k * 64 + lane] = S[k]; }
}

__device__ __forceinline__ float conv3_p(const bf16* P, int row, int col, int wpos, int row_w, float w0, float w1, float w2) {
    const bf16* p = P + (size_t)row * INP + col;
    float v = w1 * bf2f(p[0]);
    if (wpos > 0) v += w0 * bf2f(p[-INP]);
    if (wpos < row_w - 1) v += w2 * bf2f(p[INP]);
    return v;
}

template <int NI>
__device__ __forceinline__ void hyena_item(const Args& a, int l, int ba, int cblk, LAS unsigned char* lds, int tid) {
    constexpr int L = NI * 128;
    const int row0 = ba_row0(ba), row_w = ba < 2 ? GRIDW : LC;
    const bf16* P = (const bf16*)(a.ws + WS_P); bf16* MIX = (bf16*)(a.ws + WS_MIX);
    const float* T = (const float*)(a.ws + WS_FILT + (size_t)l * FILT_LAYER + (ba < 2 ? FILT_S_OFF : 0));
    const float* cw = a.in[19] + (size_t)l * 3 * 768;
    LAS float* Fb = (LAS float*)lds;
    LAS float* zb = (LAS float*)(lds + 2 * L * 16);
    const int c = tid & 3, tp = tid >> 2, ch = cblk * 4 + c;
#pragma unroll
    for (int i = 0; i < NI; ++i) { const int t = tp + 128 * i; const int col = 512 + ch;
        zb[t * 4 + c] = conv3_p(P, row0 + t, ODc + col, t % row_w, row_w, cw[col], cw[768 + col], cw[1536 + col]); }
    for (int o = 0; o < 2; ++o) {
        for (int idx = tid; idx < 2 * L; idx += NTHREADS) *(LAS f32x4*)(Fb + idx * 4) = *(const f32x4*)(T + ((size_t)o * 2 * L + idx) * 256 + cblk * 4);
        __syncthreads();
        float acc[NI];
#pragma unroll
        for (int i = 0; i < NI; ++i) acc[i] = 0.f;
        for (int s = 0; s < L; ++s) { const float zv = zb[s * 4 + c];
#pragma unroll
            for (int i = 0; i < NI; ++i) acc[i] += Fb[(tp + 128 * i - s + L) * 4 + c] * zv; }
        __syncthreads();
#pragma unroll
        for (int i = 0; i < NI; ++i) { const int t = tp + 128 * i; const int col = o * 256 + ch;
            const float g = conv3_p(P, row0 + t, ODc + col, t % row_w, row_w, cw[col], cw[768 + col], cw[1536 + col]);
            const float v = g * acc[i];
            if (o == 0) zb[t * 4 + c] = v; else MIX[(size_t)(row0 + t) * D + 768 + ch] = (bf16)f2bf(v); }
        __syncthreads();
    }
}

__device__ __forceinline__ void mlp_item(const Args& a, int l, int chunk, int g, LAS unsigned char* lds, int tid, int wave) {
    const int r0 = chunk * 128;
    const bf16* P = (const bf16*)(a.ws + WS_P); bf16* MIX = (bf16*)(a.ws + WS_MIX);
    LAS float* vv = (LAS float*)lds;
    {   const int j = tid >> 2, part = tid & 3;
        const bf16* prow = P + (size_t)(r0 + j) * INP + OCc + 256 + part * 64;
        float v[64]; float s = 0.f;
#pragma unroll
        for (int e8 = 0; e8 < 8; ++e8) { const bf16x8 raw = *(const bf16x8*)(prow + 8 * e8);
#pragma unroll
            for (int e = 0; e < 8; ++e) { const float x = gelu_tanh(bf2f((bf16)raw[e])); v[8 * e8 + e] = x; s += x; } }
        s += __shfl_xor(s, 1); s += __shfl_xor(s, 2);
        const float mu = s * (1.0f / 256.0f); float q = 0.f;
#pragma unroll
        for (int e = 0; e < 64; ++e) { const float d = v[e] - mu; q += d * d; }
        q += __shfl_xor(q, 1); q += __shfl_xor(q, 2);
        const float rstd = 1.0f / sqrtf(q * (1.0f / 256.0f) + EPS);
        if (part == g) { const float* lg = a.in[16] + (size_t)l * 256 + g * 64;
#pragma unroll
            for (int e = 0; e < 64; ++e) vv[j * 65 + e] = (v[e] - mu) * rstd * lg[e]; }
    }
    __syncthreads();
    {   const int c = tid & 63, ib = wave;
        const float* ws = a.in[17] + (((size_t)l * 4 + g) * 128 + ib * 16) * 128;
        float acc[16];
#pragma unroll
        for (int ii = 0; ii < 16; ++ii) acc[ii] = 0.f;
        for (int j = 0; j < 128; ++j) { const float x = vv[j * 65 + c];
#pragma unroll
            for (int ii = 0; ii < 16; ++ii) acc[ii] += ws[ii * 128 + j] * x; }
        const float* bs = a.in[18] + ((size_t)l * 4 + g) * 128 + ib * 16;
#pragma unroll
        for (int ii = 0; ii < 16; ++ii) { const int r = r0 + ib * 16 + ii; const float u = gelu_tanh(bf2f(P[(size_t)r * INP + OCc + g * 64 + c]));
            MIX[(size_t)r * D + 512 + g * 64 + c] = (bf16)f2bf(u * (acc[ii] + bs[ii])); }
    }
    __syncthreads();
}

#define LAUNDER_TID() int tid = tid_in; asm volatile("" : "+v"(tid)); const int lane = tid & 63; (void)lane
__device__ __forceinline__ void mix_heavy_phase(const Args& a, int l, LAS unsigned char* lds, int G, int wave, int tid_in) {
    const int bx = blockIdx.x;
    for (int it = bx; it < 34; it += G) { LAUNDER_TID(); gla_wave_unit(a, l, it, wave >> 1, wave & 1, (LAS float*)(lds + wave * 16384), lane); }
    __syncthreads();
    for (int it = (bx + G - 34 % G) % G; it < 128; it += G) { LAUNDER_TID(); hyena_item<8>(a, l, it >> 6, it & 63, lds, tid); }
    for (int it = (bx + G - 162 % G) % G; it < 320; it += G) { LAUNDER_TID(); mlp_item(a, l, it >> 2, it & 3, lds, tid, wave); }
    for (int it = (bx + G - 226 % G) % G; it < 2048; it += G) { LAUNDER_TID(); hyena_item<2>(a, l, 2 + (it >> 6), it & 63, lds, tid); }
}

__device__ __forceinline__ void mix_light_phase(const Args& a, int l, int vcu, int G, int wave, int lane) {
    const int gw = vcu * NWAVES + wave, NGW = G * NWAVES;
    const bf16* P = (const bf16*)(a.ws + WS_P); bf16* MIX = (bf16*)(a.ws + WS_MIX);
    const float* OFp = (const float*)(a.ws + WS_OF); const float* OBp = (const float*)(a.ws + WS_OB);
    const float* ca = a.in[12] + (size_t)l * 768; const float* gn = a.in[15] + (size_t)l * 64;
    const int ch = 4 * lane;
    for (int r = gw; r < M; r += NGW) {
        const int wpos = (r < NCTX) ? (r & 255) : ((r - NCTX) & 63); const int row_w = (r < NCTX) ? LC : GRIDW;
        float ya[4];
#pragma unroll
        for (int e = 0; e < 4; ++e) { float s = 0.f;
#pragma unroll
            for (int d = -1; d <= 1; ++d) { if (wpos + d >= 0 && wpos + d < row_w) { const bf16* p = P + (size_t)(r + d) * INP; s += ca[(d + 1) * 256 + ch + e] * bf2f(p[256 + ch + e]) * bf2f(p[512 + ch + e]); } }
            ya[e] = bf2f(P[(size_t)r * INP + ch + e]) * s; }
        *(GAS unsigned long long*)(MIX + (size_t)r * D + ch) = (unsigned long long)pk2(ya[0], ya[1]) | ((unsigned long long)pk2(ya[2], ya[3]) << 32);
        const f32x4 of = *(const f32x4*)(OFp + (size_t)r * 256 + ch), ob = *(const f32x4*)(OBp + (size_t)r * 256 + ch);
        const f32x4 o = of + ob; float ss = (o[0] * o[0] + o[1] * o[1]) + (o[2] * o[2] + o[3] * o[3]);
        ss += __shfl_xor(ss, 1); ss += __shfl_xor(ss, 2); ss += __shfl_xor(ss, 4); ss += __shfl_xor(ss, 8);
        const float rn = 1.0f / sqrtf(ss * (1.0f / 64.0f) + EPS);
        float yb[4];
#pragma unroll
        for (int e = 0; e < 4; ++e) { const float g = bf2f(P[(size_t)r * INP + OBc + 512 + ch + e]); yb[e] = o[e] * rn * gn[(ch + e) & 63] * silu_acc(g); }
        *(GAS unsigned long long*)(MIX + (size_t)r * D + 256 + ch) = (unsigned long long)pk2(yb[0], yb[1]) | ((unsigned long long)pk2(yb[2], yb[3]) << 32);
    }
}

__global__ void __launch_bounds__(NTHREADS, 2) fwd_kernel(Args args) {
    extern __shared__ __attribute__((aligned(16))) unsigned char lds_raw[];
    LAS unsigned char* lds = (LAS unsigned char*)lds_raw;
    volatile LAS unsigned* MISC = (volatile LAS unsigned*)(lds + MISC_OFF);
    const int tid = threadIdx.x, lane = tid & 63, wave = __builtin_amdgcn_readfirstlane(tid >> 6);
    const int G = gridDim.x; const int bx = blockIdx.x; const int vcu = (G % 8 == 0) ? (bx % 8) * (G / 8) + bx / 8 : bx;
    gu32* ctl = (gu32*)(args.ws + WS_CTL);
    for (int u = tid; u < (LDS_BYTES - LDSCTL_OFF) / 4; u += NTHREADS) ((LAS unsigned*)(lds + LDSCTL_OFF))[u] = 0u;
    __syncthreads();
    XcdBarrier bar; bar.bar = (unsigned*)(ctl + CW_BAR); bar.x = 0; bar.st = nullptr;
    if (!MK_PER_PHASE) bar = xcd_barrier_post((unsigned*)(ctl + CW_BAR), MISC + 8);
    const int lo = args.ph_lo, hi = args.ph_hi;
    for (int ph = lo; ph < hi; ++ph) {
        int kind = ph < 2 ? ph : 2 + ((ph - 2) & 7), l = ph < 2 ? 0 : (ph - 2) >> 3;
        int tid_o = tid; asm volatile("" : "+v"(tid_o), "+s"(kind), "+s"(l));
        const int lane_o = tid_o & 63;
        unsigned char* wl = args.ws + WS_W + (size_t)l * W_LAYER;
        switch (kind) {
        case 0: p0_prologue(args, lds, vcu, G, wave, lane_o, tid_o); break;
        case 1: row_phase(args, 0, 0, vcu, G, wave, lane_o); break;
        case 2: {
            pg8::Gemm g{(const pg8::bf16_t*)(args.ws + WS_H), (const pg8::bf16_t*)(wl + W_IN), M, INP, D}; pg8::StaticOrder S; S.init(M, INP, G, bx);
            pg8::EpiBf16<0> E{(pg8::bf16_t*)(args.ws + WS_P), INP, nullptr, 0, 0, 1.f};
            pg8::gemm_phase<pg8::EpiBf16<0>, pg8::StaticOrder, true, true>(lds + RING_OFF, g, S, E, tid_o); } break;
        case 3: mix_heavy_phase(args, l, lds, G, wave, tid_o); break;
        case 4: mix_light_phase(args, l, vcu, G, wave, lane_o); break;
        case 5: {
            pg8::Gemm g{(const pg8::bf16_t*)(args.ws + WS_MIX), (const pg8::bf16_t*)(wl + W_OUT), M, D, D}; pg8::StaticOrder S; S.init(M, D, G, bx);
            pg8::EpiF32 E{(float*)(args.ws + WS_MF), D};
            pg8::gemm_phase<pg8::EpiF32, pg8::StaticOrder, true, true>(lds + RING_OFF, g, S, E, tid_o); } break;
        case 6: row_phase(args, l, 1, vcu, G, wave, lane_o); break;
        case 7: {
            pg8::Gemm g{(const pg8::bf16_t*)(args.ws + WS_H), (const pg8::bf16_t*)(wl + W_13), M, 2 * FF, D}; pg8::StaticOrder S; S.init(M, 2 * FF, G, bx);
            pg8::EpiSwiGLU E{(pg8::bf16_t*)(args.ws + WS_P), FF};
            pg8::gemm_phase<pg8::EpiSwiGLU, pg8::StaticOrder, true, true>(lds + RING_OFF, g, S, E, tid_o); } break;
        case 8: {
            pg8::Gemm g{(const pg8::bf16_t*)(args.ws + WS_P), (const pg8::bf16_t*)(wl + W_2), M, D, FF}; pg8::StaticOrder S; S.init(M, D, G, bx);
            pg8::EpiF32 E{(float*)(args.ws + WS_MF), D};
            pg8::gemm_phase<pg8::EpiF32, pg8::StaticOrder, true, true>(lds + RING_OFF, g, S, E, tid_o); } break;
        default: row_phase(args, l, 2, vcu, G, wave, lane_o); break;
        }
        if (ph + 1 < hi) xcd_barrier(bar);
    }
}


extern "C" void kernel_launch(void* const* d_in, const int* in_sizes, int n_in, void* d_out, int out_size, void* d_ws, size_t ws_size, hipStream_t stream) {
    static int grid = 0;
    if (grid == 0) {
        if (n_in != 32 || ws_size < WS_END) { fprintf(stderr, "kernel_launch: unexpected inputs (n_in %d, ws %zu)\n", n_in, ws_size); grid = -1; return; }
        int dev = 0, cus = 0, per_cu = 0;
        if (hipGetDevice(&dev) != hipSuccess || hipDeviceGetAttribute(&cus, hipDeviceAttributeMultiprocessorCount, dev) != hipSuccess) { grid = -1; return; }
        if (hipFuncSetAttribute((const void*)fwd_kernel, hipFuncAttributeMaxDynamicSharedMemorySize, LDS_BYTES) != hipSuccess) { fprintf(stderr, "kernel_launch: hipFuncSetAttribute failed\n"); grid = -1; return; }
        if (hipOccupancyMaxActiveBlocksPerMultiprocessor(&per_cu, (const void*)fwd_kernel, NTHREADS, LDS_BYTES) != hipSuccess || per_cu < 1) { fprintf(stderr, "kernel_launch: occupancy query says %d blocks per CU\n", per_cu); }
        (void)hipGetLastError();
        grid = cus;
    }
    if (grid < 0) return;
    (void)hipMemsetAsync((char*)d_ws + WS_CTL, 0, CTL_ZERO_BYTES, stream);
    Args a{};
    for (int i = 0; i < 32; ++i) a.in[i] = (const float*)d_in[i];
    a.out = (float*)d_out; a.ws = (unsigned char*)d_ws;
#if MK_PER_PHASE
    for (int p = 0; p < NPHASE; ++p) { a.ph_lo = p; a.ph_hi = p + 1; a.li = p; hipLaunchKernelGGL(fwd_kernel, dim3(grid), dim3(NTHREADS), LDS_BYTES, stream, a); }
#else
    a.ph_lo = 0; a.ph_hi = NPHASE; a.li = 0;
    hipLaunchKernelGGL(fwd_kernel, dim3(grid), dim3(NTHREADS), LDS_BYTES, stream, a);
#endif
}
```

```cpp
#include <hip/hip_runtime.h>
#include <cstdio>
#include <cstdint>
namespace pg8 {
#define PG8_LAS __attribute__((address_space(3)))
typedef unsigned short bf16_t;
typedef short bf16x8 __attribute__((ext_vector_type(8)));
typedef float f32x4 __attribute__((ext_vector_type(4)));
typedef unsigned u32x4 __attribute__((ext_vector_type(4)));
constexpr int BM = 256, BK = 64, HALF = 128, HTB = HALF * BK * 2  , STAGE_BYTES = 8 * HTB, NXCD = 8, WGM = 8;

__host__ __device__ __forceinline__ int lds_byte(int r, int c) { const int st = (r >> 4) * 2 + (c >> 5), rr = r & 15, cc = c & 31, ob = rr * 64 + cc * 2; return st * 1024 + (ob ^ (((ob >> 9) & 1) << 5)); }
__host__ __device__ __forceinline__ void stage_rc(int b, int& R, int& C) { const int st = b / 1024, sb = b % 1024, swz = sb ^ (((sb >> 9) & 1) << 5); R = (st >> 1) * 16 + swz / 64; C = (st & 1) * 32 + (swz % 64) / 2; }
__host__ __device__ __forceinline__ int perm32(int rho) { const int n = rho >> 4, i = rho & 15; return 8 * (i >> 2) + 4 * n + (i & 3); }

struct Unit { int pm, pn; };
struct Gemm { const bf16_t* A; const bf16_t* Bt; int M, N, K; };

struct StaticOrder {
    int nM, nN, nwg, G, c;
    __host__ __device__ void init(int M, int N, int G_, int c_) { nM = M / BM; nN = N / BM; nwg = nM * nN; G = G_; c = c_; }
    __host__ __device__ bool next(int i, Unit& u) const {
        const long L = (long)i * G + c; if (L >= nwg) return false;
        int wgid = (int)L; { const int q = nwg / NXCD, r = nwg % NXCD, xcd = wgid % NXCD, off = wgid / NXCD; wgid = (xcd < r ? xcd * (q + 1) : r * (q + 1) + (xcd - r) * q) + off; }
        const int nig = WGM * nN, gid = wgid / nig, fm = gid * WGM, gsz = (nM - fm) < WGM ? (nM - fm) : WGM;
        u.pm = fm + ((wgid % nig) % gsz); u.pn = (wgid % nig) / gsz; return true;
    }
    __device__ __forceinline__ void a_ready(const Unit&) const {}
    __device__ __forceinline__ void done(const Unit&) const {}
};

__device__ __forceinline__ unsigned cvt_pk_bf16(float lo, float hi) { unsigned r; asm volatile("v_cvt_pk_bf16_f32 %0, %1, %2" : "=v"(r) : "v"(lo), "v"(hi)); return r; }
typedef float f32x2 __attribute__((ext_vector_type(2)));
__device__ __forceinline__ f32x2 gelu_pk(f32x2 v) {
    const f32x2 av = __builtin_elementwise_abs(v), d = av * 0.2316418882f + 1.0f;
    f32x2 t; t.x = __builtin_amdgcn_rcpf(d.x); t.y = __builtin_amdgcn_rcpf(d.y);
    f32x2 q = t * 0.5307027145f + (-0.7265760135f); q = q * t + 0.7107068705f; q = q * t + (-0.142248368f); q = q * t + 0.127414796f; q = q * t;
    const f32x2 s = (v * v) * (-0.72134752044f);
    f32x2 e; e.x = __builtin_amdgcn_exp2f(s.x); e.y = __builtin_amdgcn_exp2f(s.y);
    const f32x2 m = v * (q * e), r = v - m;
    f32x2 o; o.x = v.x < 0.f ? m.x : r.x; o.y = v.y < 0.f ? m.y : r.y; return o;
}

template <int ACT  > struct EpiBf16 {
    static constexpr bool PERM = true, AFTER_DRAIN = false; static_assert(ACT == 0 || ACT == 1, "EpiBf16: ACT is 0 (none) or 1 (gelu_pk)");
    bf16_t* O; int ldc; const float* bias; int split_cols; size_t split_stride; float scale0;
    __device__ __forceinline__ void operator()(const f32x4 (&acc)[2][2][4][2], const Unit& u, int wr, int wc, int fr, int fq) const {
        const int row0 = u.pm * BM + wr * 64 + fr; int colt = u.pn * BM; bf16_t* base = O;
        float sc = 1.f; if (split_cols) { const int t = colt / split_cols; base += (size_t)t * split_stride; colt -= t * split_cols; if (t == 0) sc = scale0; }
        const int col0 = colt + wc * 32 + 8 * fq, bcol0 = u.pn * BM + wc * 32 + 8 * fq;
        f32x4 bv[2][2];
#pragma unroll
        for (int bj = 0; bj < 2; ++bj)
#pragma unroll
            for (int n = 0; n < 2; ++n) bv[bj][n] = bias ? *(const f32x4*)(bias + bcol0 + bj * HALF + 4 * n) : (f32x4){0.f, 0.f, 0.f, 0.f};
#pragma unroll
        for (int ai = 0; ai < 2; ++ai)
#pragma unroll
            for (int m = 0; m < 4; ++m) { bf16_t* rowp = base + (size_t)(row0 + ai * HALF + m * 16) * ldc + col0;
#pragma unroll
                for (int bj = 0; bj < 2; ++bj) { f32x4 v0 = acc[ai][bj][m][0] + bv[bj][0], v1 = acc[ai][bj][m][1] + bv[bj][1];
                    if (ACT == 1) { f32x2 a = gelu_pk((f32x2){v0[0], v0[1]}), b = gelu_pk((f32x2){v0[2], v0[3]}), c = gelu_pk((f32x2){v1[0], v1[1]}), d = gelu_pk((f32x2){v1[2], v1[3]});
                        v0 = (f32x4){a.x, a.y, b.x, b.y}; v1 = (f32x4){c.x, c.y, d.x, d.y}; }
                    v0 = v0 * sc; v1 = v1 * sc; u32x4 w; w.x = cvt_pk_bf16(v0[0], v0[1]); w.y = cvt_pk_bf16(v0[2], v0[3]); w.z = cvt_pk_bf16(v1[0], v1[1]); w.w = cvt_pk_bf16(v1[2], v1[3]);
                    *(u32x4*)(rowp + bj * HALF) = w; } }
    }
};

struct PanelStats {
    unsigned* xbuf;
    unsigned* cnt;
    unsigned* tmo;
    int ntn; float eps;
    unsigned code;
    __device__ __forceinline__ bool run(const f32x4 (&v)[2][2][4][2], const Unit& u, int wr, int wc, int fr, int fq, PG8_LAS unsigned char* lds, int wid, int lane) const {
        typedef float f32x2v __attribute__((ext_vector_type(2)));
        PG8_LAS f32x2v* P = (PG8_LAS f32x2v*)lds;
        PG8_LAS f32x2v* S = (PG8_LAS f32x2v*)(lds + 8192);
        PG8_LAS unsigned* flag = (PG8_LAS unsigned*)(lds + 8192 + 2048);
#pragma unroll
        for (int ai = 0; ai < 2; ++ai)
#pragma unroll
            for (int m = 0; m < 4; ++m) {
                float s = 0.f;
#pragma unroll
                for (int bj = 0; bj < 2; ++bj)
#pragma unroll
                    for (int n = 0; n < 2; ++n) { const f32x4 x = v[ai][bj][m][n]; s += (x[0] + x[1]) + (x[2] + x[3]); }
                s += __shfl_xor(s, 16); s += __shfl_xor(s, 32);
                const float mw = s * (1.0f / 64.0f); float q = 0.f;
#pragma unroll
                for (int bj = 0; bj < 2; ++bj)
#pragma unroll
                    for (int n = 0; n < 2; ++n) { const f32x4 d = v[ai][bj][m][n] - mw; q += (d[0] * d[0] + d[1] * d[1]) + (d[2] * d[2] + d[3] * d[3]); }
                q += __shfl_xor(q, 16); q += __shfl_xor(q, 32);
                if (fq == 0) P[(ai * HALF + wr * 64 + m * 16 + fr) * 4 + wc] = (f32x2v){mw, q};
            }
        asm volatile("s_waitcnt lgkmcnt(0)" ::: "memory"); __builtin_amdgcn_s_barrier(); asm volatile("" ::: "memory");
#if defined(BROKEN_EXCHANGE_NO_WAIT)
#warning BROKEN CONTROL BUILD: the row-statistics exchange does not wait; results are wrong by design
        if (blockIdx.x >= 64) { const long long t0_ = clock64(); while (clock64() - t0_ < 60000) __builtin_amdgcn_s_sleep(8); }
#endif
        const int row = wid * 32 + (lane & 31);
        if (lane < 32) {
            const f32x2v a = P[row * 4 + 0], b = P[row * 4 + 1], c = P[row * 4 + 2], d = P[row * 4 + 3];
            const float mt = (a.x + b.x + c.x + d.x) * 0.25f;
            const float da = a.x - mt, db = b.x - mt, dc = c.x - mt, dd = d.x - mt;
            const float m2 = (a.y + b.y) + (c.y + d.y) + 64.0f * ((da * da + db * db) + (dc * dc + dd * dd));
            unsigned long long* slot = (unsigned long long*)xbuf + ((size_t)(u.pm * BM + row) * 4 + u.pn);
            __hip_atomic_store(slot, ((unsigned long long)__float_as_uint(m2) << 32) | __float_as_uint(mt), __ATOMIC_RELAXED, __HIP_MEMORY_SCOPE_AGENT);
        }
        asm volatile("s_waitcnt vmcnt(0)" ::: "memory");
        if (lane == 0) __hip_atomic_fetch_add(cnt + 64 * u.pm, 1u, __ATOMIC_RELAXED, __HIP_MEMORY_SCOPE_AGENT);
        if (wid == 0) {
            bool dead = false; const unsigned long long t0 = __builtin_amdgcn_s_memrealtime(); const unsigned want = 8u * (unsigned)ntn;
            for (;;) {
#if defined(BROKEN_EXCHANGE_NO_WAIT)
                break;
#endif
                if ((unsigned)__builtin_amdgcn_readfirstlane(__hip_atomic_load(cnt + 64 * u.pm, __ATOMIC_RELAXED, __HIP_MEMORY_SCOPE_AGENT)) >= want) break;
                if (__builtin_amdgcn_s_memrealtime() - t0 > 2000000ull) {
                    if (lane == 0) { unsigned expect = 0u; __hip_atomic_compare_exchange_strong(tmo + 1, &expect, code | (unsigned)(u.pm & 0xff), __ATOMIC_RELAXED, __ATOMIC_RELAXED, __HIP_MEMORY_SCOPE_AGENT);
                                     __hip_atomic_store(tmo, 1u, __ATOMIC_RELAXED, __HIP_MEMORY_SCOPE_AGENT); }
                    dead = true; break; }
                __builtin_amdgcn_s_sleep(2);
            }
            __builtin_amdgcn_fence(__ATOMIC_ACQUIRE, "agent");
            if (lane == 0) flag[0] = dead ? 1u : 0u;
        }
        asm volatile("s_waitcnt vmcnt(0) lgkmcnt(0)" ::: "memory"); __builtin_amdgcn_s_barrier(); asm volatile("" ::: "memory");
        const bool bad = flag[0] != 0u;
        if (lane < 32) {
            const unsigned long long* slot = (const unsigned long long*)xbuf + (size_t)(u.pm * BM + row) * 4; float mt[4], m2[4]; float ms = 0.f;
#pragma unroll
            for (int t = 0; t < 4; ++t) { if (t < ntn) { const unsigned long long w = __hip_atomic_load(slot + t, __ATOMIC_RELAXED, __HIP_MEMORY_SCOPE_AGENT); mt[t] = __uint_as_float((unsigned)w); m2[t] = __uint_as_float((unsigned)(w >> 32)); } else { mt[t] = 0.f; m2[t] = 0.f; } ms += mt[t]; }
            const float mean = ms / (float)ntn; float q = 0.f;
#pragma unroll
            for (int t = 0; t < 4; ++t) if (t < ntn) { const float dm = mt[t] - mean; q += m2[t] + 256.0f * dm * dm; }
            S[row] = (f32x2v){mean, 1.0f / sqrtf(q / (256.0f * (float)ntn) + eps)};
        }
        asm volatile("s_waitcnt lgkmcnt(0)" ::: "memory"); __builtin_amdgcn_s_barrier(); asm volatile("" ::: "memory");
        return bad;
    }
};
struct EpiLnRes {
    static constexpr bool PERM = false, AFTER_DRAIN = true;
    const float* base; float* out; int ldc; const float* bias; PanelStats st; unsigned poison;
    __device__ __forceinline__ void fused(f32x4 (&acc)[2][2][4][2], const Unit& u, int wr, int wc, int fr, int fq, PG8_LAS unsigned char* lds, int wid, int lane) const {
        typedef float f32x2v __attribute__((ext_vector_type(2)));
        const PG8_LAS f32x2v* S = (const PG8_LAS f32x2v*)(lds + 8192);
        const int col0 = u.pn * BM + wc * 32 + 4 * fq;
#pragma unroll
        for (int bj = 0; bj < 2; ++bj)
#pragma unroll
            for (int n = 0; n < 2; ++n) { const f32x4 bv = bias ? *(const f32x4*)(bias + col0 + bj * HALF + n * 16) : (f32x4){0.f, 0.f, 0.f, 0.f};
#pragma unroll
                for (int ai = 0; ai < 2; ++ai)
#pragma unroll
                    for (int m = 0; m < 4; ++m) acc[ai][bj][m][n] += bv; }
        f32x4 pre[4][2][2];
#pragma unroll
        for (int m = 0; m < 4; ++m) { const size_t off = (size_t)(u.pm * BM + wr * 64 + m * 16 + fr) * ldc + col0;
#pragma unroll
            for (int bj = 0; bj < 2; ++bj)
#pragma unroll
                for (int n = 0; n < 2; ++n) pre[m][bj][n] = *(const f32x4*)(base + off + bj * HALF + n * 16); }
        const bool bad = st.run(acc, u, wr, wc, fr, fq, lds, wid, lane) || poison != 0u;
        const float qnan = __builtin_nanf("");
#pragma unroll
        for (int ai = 0; ai < 2; ++ai)
#pragma unroll
            for (int m = 0; m < 4; ++m) { const int r = ai * HALF + wr * 64 + m * 16 + fr; const f32x2v sr = S[r]; const size_t off = (size_t)(u.pm * BM + r) * ldc + col0;
#pragma unroll
                for (int bj = 0; bj < 2; ++bj)
#pragma unroll
                    for (int n = 0; n < 2; ++n) { const f32x4 bs = ai == 0 ? pre[m][bj][n] : *(const f32x4*)(base + off + bj * HALF + n * 16); f32x4 o = bs + (acc[ai][bj][m][n] - sr.x) * sr.y;
                        if (bad) o = (f32x4){qnan, qnan, qnan, qnan}; *(f32x4*)(out + off + bj * HALF + n * 16) = o; }
                if (m & 1) asm volatile("" ::: "memory"); }
    }
};
struct EpiLnResLn {
    static constexpr bool PERM = false, AFTER_DRAIN = true;
    const float* base; float* out; bf16_t* xn; int ldc; const float* bias; PanelStats st1, st2; unsigned poison;
    __device__ __forceinline__ void fused(f32x4 (&acc)[2][2][4][2], const Unit& u, int wr, int wc, int fr, int fq, PG8_LAS unsigned char* lds, int wid, int lane) const {
        typedef float f32x2v __attribute__((ext_vector_type(2))); typedef unsigned u32x2v __attribute__((ext_vector_type(2)));
        const PG8_LAS f32x2v* S = (const PG8_LAS f32x2v*)(lds + 8192);
        const int col0 = u.pn * BM + wc * 32 + 4 * fq;
#pragma unroll
        for (int bj = 0; bj < 2; ++bj)
#pragma unroll
            for (int n = 0; n < 2; ++n) { const f32x4 bv = bias ? *(const f32x4*)(bias + col0 + bj * HALF + n * 16) : (f32x4){0.f, 0.f, 0.f, 0.f};
#pragma unroll
                for (int ai = 0; ai < 2; ++ai)
#pragma unroll
                    for (int m = 0; m < 4; ++m) acc[ai][bj][m][n] += bv; }
        bool bad = st1.run(acc, u, wr, wc, fr, fq, lds, wid, lane) || poison != 0u;
        const float qnan = __builtin_nanf("");
#pragma unroll
        for (int ai = 0; ai < 2; ++ai)
#pragma unroll
            for (int m = 0; m < 4; ++m) { const int r = ai * HALF + wr * 64 + m * 16 + fr; const f32x2v sr = S[r]; const size_t off = (size_t)(u.pm * BM + r) * ldc + col0;
#pragma unroll
                for (int bj = 0; bj < 2; ++bj)
#pragma unroll
                    for (int n = 0; n < 2; ++n) { const f32x4 bs = *(const f32x4*)(base + off + bj * HALF + n * 16); acc[ai][bj][m][n] = bs + (acc[ai][bj][m][n] - sr.x) * sr.y; }
                asm volatile("" : "+v"(acc[ai][0][m][0]), "+v"(acc[ai][0][m][1]), "+v"(acc[ai][1][m][0]), "+v"(acc[ai][1][m][1]));
                if (m & 1) asm volatile("" ::: "memory"); }
        const bool bad1 = bad;
        bad = st2.run(acc, u, wr, wc, fr, fq, lds, wid, lane) || bad;
#pragma unroll
        for (int ai = 0; ai < 2; ++ai)
#pragma unroll
            for (int m = 0; m < 4; ++m) { const int r = ai * HALF + wr * 64 + m * 16 + fr; const f32x2v sr = S[r]; const size_t off = (size_t)(u.pm * BM + r) * ldc + col0;
#pragma unroll
                for (int bj = 0; bj < 2; ++bj)
#pragma unroll
                    for (int n = 0; n < 2; ++n) { const f32x4 x1 = acc[ai][bj][m][n]; *(f32x4*)(out + off + bj * HALF + n * 16) = bad1 ? (f32x4){qnan, qnan, qnan, qnan} : x1;
                        const f32x4 o = (x1 - sr.x) * sr.y; u32x2v w; w.x = cvt_pk_bf16(o[0], o[1]); w.y = cvt_pk_bf16(o[2], o[3]);
                        if (bad) { w.x = 0x7fc07fc0u; w.y = 0x7fc07fc0u; } *(u32x2v*)(xn + off + bj * HALF + n * 16) = w; }
                asm volatile("" ::: "memory"); }
    }
};

template <class Epi, class Sched, bool ALIGN_EPI = false, bool SP2 = false>
__device__ __forceinline__ void gemm_phase(PG8_LAS unsigned char* lds, const Gemm g, const Sched& S, const Epi& E, const int tid) {
    const int wid = __builtin_amdgcn_readfirstlane(tid >> 6), lane = tid & 63, wr = wid >> 2, wc = wid & 3, fr = lane & 15, fq = lane >> 4;
    const int K = g.K, nt = K / BK;
    unsigned voffA[2], voffB[2];
#pragma unroll
    for (int i = 0; i < 2; ++i) { int R, C; stage_rc(tid * 16 + i * 8192, R, C); const int Rb = Epi::PERM ? ((R & ~31) + perm32(R & 31)) : R;
        voffA[i] = (unsigned)(R * K + C) * 2u; voffB[i] = (unsigned)(Rb * K + C) * 2u; }
    const size_t kstep = (size_t)(BK * 2);
    const size_t hstep = (size_t)HALF * K * 2;
    const size_t tstep = 2 * hstep;
    const unsigned ldsw = (unsigned)wid * 1024u;
    const int aoff = lds_byte(wr * 64 + fr, fq * 8), boff = lds_byte(wc * 32 + fr, fq * 8);
#define PG8_SA(b, h) (((b) * 2 + (h)) * HTB)
#define PG8_SB(b, h) ((4 + (b) * 2 + (h)) * HTB)
#define PG8_STAGE(bufoff, gbase, voff) do { _Pragma("unroll") for (int _i = 0; _i < 2; ++_i) \
        __builtin_amdgcn_global_load_lds((const unsigned*)((const char*)(gbase) + (voff)[_i]), (PG8_LAS unsigned*)(lds + (bufoff) + ldsw + _i * 8192), 16, 0, 0); } while (0)
#define PG8_LDA(dst, b, h) do { _Pragma("unroll") for (int m = 0; m < 4; ++m) _Pragma("unroll") for (int k = 0; k < 2; ++k) dst[m][k] = *(const PG8_LAS bf16x8*)(lds + PG8_SA(b, h) + aoff + m * 2048 + k * 1024); } while (0)
#define PG8_LDB(dst, b, h) do { _Pragma("unroll") for (int n = 0; n < 2; ++n) _Pragma("unroll") for (int k = 0; k < 2; ++k) dst[n][k] = *(const PG8_LAS bf16x8*)(lds + PG8_SB(b, h) + boff + n * 2048 + k * 1024); } while (0)
#define PG8_MMA(ai, bj, At, Bt) do { __builtin_amdgcn_s_setprio(1); _Pragma("unroll") for (int m = 0; m < 4; ++m) _Pragma("unroll") for (int n = 0; n < 2; ++n) _Pragma("unroll") for (int k = 0; k < 2; ++k) \
        acc[ai][bj][m][n] = __builtin_amdgcn_mfma_f32_16x16x32_bf16(Bt[n][k], At[m][k], acc[ai][bj][m][n], 0, 0, 0); __builtin_amdgcn_s_setprio(0); } while (0)
#define PG8_WAIT_V(n) asm volatile("s_waitcnt vmcnt(" #n ")" ::: "memory")
#define PG8_WAIT_L(n) asm volatile("s_waitcnt lgkmcnt(" #n ")" ::: "memory")
#define PG8_BAR __builtin_amdgcn_s_barrier()
#define PG8_SCHED __builtin_amdgcn_sched_barrier(0)
    Unit cur, nxt; int ui = 0;
    if (!S.next(0, cur)) return;
    f32x4 acc[2][2][4][2];
#pragma unroll
    for (int a = 0; a < 2; ++a)
#pragma unroll
        for (int b = 0; b < 2; ++b)
#pragma unroll
            for (int m = 0; m < 4; ++m)
#pragma unroll
                for (int n = 0; n < 2; ++n) acc[a][b][m][n] = (f32x4){0.f, 0.f, 0.f, 0.f};
    bf16x8 At[4][2], B0[2][2], B1[2][2];
    const char* cA = (const char*)g.A + (size_t)cur.pm * tstep; const char* cB = (const char*)g.Bt + (size_t)cur.pn * tstep;
    S.a_ready(cur);
    if constexpr (SP2) {
        PG8_STAGE(PG8_SB(0, 0), cB, voffB); PG8_STAGE(PG8_SB(0, 1), cB + hstep, voffB); PG8_STAGE(PG8_SA(0, 0), cA, voffA); PG8_STAGE(PG8_SA(0, 1), cA + hstep, voffA);
        if (wr == 1) PG8_BAR;
        PG8_WAIT_V(2); PG8_BAR;
        PG8_STAGE(PG8_SB(1, 0), cB + kstep, voffB); PG8_STAGE(PG8_SA(1, 0), cA + kstep, voffA); PG8_STAGE(PG8_SB(1, 1), cB + hstep + kstep, voffB);
        PG8_WAIT_V(6); PG8_BAR;
    } else {
        PG8_STAGE(PG8_SB(0, 0), cB, voffB); PG8_STAGE(PG8_SA(0, 0), cA, voffA); PG8_STAGE(PG8_SB(0, 1), cB + hstep, voffB); PG8_STAGE(PG8_SA(0, 1), cA + hstep, voffA);
        if (wr == 1) PG8_BAR;
        PG8_WAIT_V(4); PG8_BAR;
        PG8_STAGE(PG8_SB(1, 0), cB + kstep, voffB); PG8_STAGE(PG8_SA(1, 0), cA + kstep, voffA); PG8_STAGE(PG8_SB(1, 1), cB + hstep + kstep, voffB);
        PG8_WAIT_V(6); PG8_BAR;
    }
    for (;;) {
        const bool has_next = S.next(ui + 1, nxt);
        const char* nA = has_next ? (const char*)g.A + (size_t)nxt.pm * tstep : cA; const char* nB = has_next ? (const char*)g.Bt + (size_t)nxt.pn * tstep : cB;
        for (int t = 0; t < nt; t += 2) {
            const bool last = (t == nt - 2);
            const char* a1 = cA + (size_t)(t + 1) * kstep;
            const char* a2 = last ? nA : cA + (size_t)(t + 2) * kstep; const char* b2 = last ? nB : cB + (size_t)(t + 2) * kstep;
            const char* a3 = a2 + kstep; const char* b3 = b2 + kstep;
            if (last && has_next) S.a_ready(nxt);
            if constexpr (SP2) {
            PG8_LDB(B0, 0, 0); PG8_LDB(B1, 0, 1); PG8_SCHED; PG8_LDA(At, 0, 0); PG8_STAGE(PG8_SA(1, 1), a1 + hstep, voffA);
            PG8_WAIT_V(8); PG8_WAIT_L(0); PG8_BAR; PG8_MMA(0, 0, At, B0); PG8_MMA(0, 1, At, B1); PG8_BAR; PG8_SCHED;
            PG8_LDA(At, 0, 1); PG8_STAGE(PG8_SB(0, 0), b2, voffB); PG8_STAGE(PG8_SB(0, 1), b2 + hstep, voffB); PG8_STAGE(PG8_SA(0, 0), a2, voffA);
            PG8_WAIT_V(8); PG8_WAIT_L(0); PG8_BAR; PG8_MMA(1, 0, At, B0); PG8_MMA(1, 1, At, B1); PG8_BAR; PG8_SCHED;
            PG8_LDB(B0, 1, 0); PG8_LDB(B1, 1, 1); PG8_SCHED; PG8_LDA(At, 1, 0); PG8_STAGE(PG8_SA(0, 1), a2 + hstep, voffA);
            PG8_WAIT_V(8); PG8_WAIT_L(0); PG8_BAR; PG8_MMA(0, 0, At, B0); PG8_MMA(0, 1, At, B1); PG8_BAR; PG8_SCHED;
            PG8_LDA(At, 1, 1); PG8_STAGE(PG8_SB(1, 0), b3, voffB); PG8_STAGE(PG8_SB(1, 1), b3 + hstep, voffB); PG8_STAGE(PG8_SA(1, 0), a3, voffA);
            PG8_WAIT_V(8); PG8_WAIT_L(0); PG8_BAR; PG8_MMA(1, 0, At, B0); PG8_MMA(1, 1, At, B1); PG8_BAR; PG8_SCHED;
            } else {
            PG8_LDB(B0, 0, 0); PG8_SCHED; PG8_LDA(At, 0, 0); PG8_STAGE(PG8_SA(1, 1), a1 + hstep, voffA);
            PG8_WAIT_L(8); PG8_BAR; PG8_WAIT_L(0); PG8_MMA(0, 0, At, B0); PG8_BAR; PG8_SCHED;
            PG8_LDB(B1, 0, 1); PG8_STAGE(PG8_SB(0, 0), b2, voffB);
            PG8_BAR; PG8_WAIT_L(0); PG8_MMA(0, 1, At, B1); PG8_BAR;
            PG8_LDA(At, 0, 1); PG8_STAGE(PG8_SA(0, 0), a2, voffA);
            PG8_BAR; PG8_WAIT_L(0); PG8_MMA(1, 0, At, B0); PG8_BAR; PG8_SCHED;
            PG8_STAGE(PG8_SB(0, 1), b2 + hstep, voffB);
            PG8_WAIT_V(6); PG8_BAR; PG8_MMA(1, 1, At, B1); PG8_BAR;
            PG8_LDB(B0, 1, 0); PG8_SCHED; PG8_LDA(At, 1, 0); PG8_STAGE(PG8_SA(0, 1), a2 + hstep, voffA);
            PG8_WAIT_L(8); PG8_BAR; PG8_WAIT_L(0); PG8_MMA(0, 0, At, B0); PG8_BAR; PG8_SCHED;
            PG8_LDB(B1, 1, 1); PG8_STAGE(PG8_SB(1, 0), b3, voffB);
            PG8_BAR; PG8_WAIT_L(0); PG8_MMA(0, 1, At, B1); PG8_BAR;
            PG8_LDA(At, 1, 1); PG8_STAGE(PG8_SA(1, 0), a3, voffA);
            PG8_BAR; PG8_WAIT_L(0); PG8_MMA(1, 0, At, B0); PG8_BAR; PG8_SCHED;
            PG8_STAGE(PG8_SB(1, 1), b3 + hstep, voffB);
            PG8_WAIT_V(6); PG8_BAR; PG8_MMA(1, 1, At, B1); PG8_BAR;
            }
        }
        if constexpr (ALIGN_EPI) { if (wr == 0) PG8_BAR; }
        if constexpr (!Epi::AFTER_DRAIN) { E(acc, cur, wr, wc, fr, fq); S.done(cur); }
        if (!has_next) break;
#pragma unroll
        for (int a = 0; a < 2; ++a)
#pragma unroll
            for (int b = 0; b < 2; ++b)
#pragma unroll
                for (int m = 0; m < 4; ++m)
#pragma unroll
                    for (int n = 0; n < 2; ++n) acc[a][b][m][n] = (f32x4){0.f, 0.f, 0.f, 0.f};
        cur = nxt; cA = nA; cB = nB; ++ui;
        if constexpr (ALIGN_EPI) { if (wr == 1) PG8_BAR; }
    }
    PG8_WAIT_V(0);
    if constexpr (!ALIGN_EPI) { if (wr == 0) PG8_BAR; }
    PG8_BAR;
    if constexpr (Epi::AFTER_DRAIN) { E.fused(acc, cur, wr, wc, fr, fq, lds, wid, lane); S.done(cur); }
#undef PG8_SA
#undef PG8_SB
#undef PG8_STAGE
#undef PG8_LDA
#undef PG8_LDB
#undef PG8_MMA
#undef PG8_WAIT_V
#undef PG8_WAIT_L
#undef PG8_BAR
#undef PG8_SCHED
}
}

#ifndef PG8_SP2
#define PG8_SP2 true
#endif
#ifndef PG8_ALIGN
#define PG8_ALIGN true
#endif

#define GAS __attribute__((address_space(1)))
#define LAS __attribute__((address_space(3)))
typedef unsigned short bf16;
typedef unsigned v4u __attribute__((ext_vector_type(4)));
typedef float f32x4 __attribute__((ext_vector_type(4)));
typedef short bf16x8 __attribute__((ext_vector_type(8)));
typedef GAS unsigned gu32;
typedef GAS unsigned long long gu64;
#define RLX_AGENT __ATOMIC_RELAXED, __HIP_MEMORY_SCOPE_AGENT
#define LDS_WAIT() asm volatile("s_waitcnt lgkmcnt(0)" ::: "memory")
#define VM_WAIT() asm volatile("s_waitcnt vmcnt(0)" ::: "memory")
__device__ __forceinline__ unsigned long long rt() { return __builtin_amdgcn_s_memrealtime(); }
__device__ __forceinline__ unsigned f2bf(float f) { unsigned u = __builtin_bit_cast(unsigned, f); return (u + 0x7fffu + ((u >> 16) & 1u)) >> 16; }
__device__ __forceinline__ unsigned pk2(float lo, float hi) { return f2bf(lo) | (f2bf(hi) << 16); }

#define XB_TMO      128
#define XB_XCNT(j)  (256  + 64 * (j))
#define XB_XSUB(j)  (1280 + 64 * (j))
#define XB_XGEN(j)  (2304 + 64 * (j))
#define XB_TOP      3328
#define XB_TOPGEN   3392
#define XCD_BAR_WORDS 3456
#define XB_SPIN_CAP (1u << 18)

__device__ __forceinline__ unsigned xb_ld(unsigned* p)              { return __hip_atomic_load(p, __ATOMIC_RELAXED, __HIP_MEMORY_SCOPE_AGENT); }
__device__ __forceinline__ unsigned xb_add(unsigned* p, unsigned v) { return __hip_atomic_fetch_add(p, v, __ATOMIC_RELAXED, __HIP_MEMORY_SCOPE_AGENT); }
__device__ __forceinline__ unsigned xb_xcc_id() { return (unsigned)__builtin_amdgcn_s_getreg((3 << 11) | 20) & 0xFu; }
#define XB_SPIN(cond, bar) do { unsigned _sp = 0; while (cond) { __builtin_amdgcn_s_sleep(1); \
    if ((++_sp & 255u) == 0u) { if (xb_ld(&(bar)[XB_TMO])) break; if (_sp > XB_SPIN_CAP) { atomicAdd(&(bar)[XB_TMO], 1u); break; } } } } while (0)

struct XcdBarrier {
    unsigned* bar; unsigned x;
    volatile LAS unsigned* st;
};

__device__ __forceinline__ XcdBarrier xcd_barrier_post(unsigned* bar, volatile LAS unsigned* st) {
    XcdBarrier b; b.bar = bar; b.x = xb_xcc_id(); b.st = st;
    if (threadIdx.x == 0) (void)xb_add(&bar[XB_XCNT(b.x)], 1u);
    return b;
}
__device__ __forceinline__ void xcd_barrier_complete(unsigned* bar, unsigned x, unsigned& nloc, unsigned& nx) {
    const unsigned G = gridDim.x * gridDim.y * gridDim.z;
    unsigned sum, cnt, mine, sp = 0u;
    for (;;) {
        sum = 0u; cnt = 0u; mine = 0u;
#pragma unroll
        for (unsigned j = 0; j < 16; ++j) { const unsigned c = xb_ld(&bar[XB_XCNT(j)]); sum += c; cnt += (c > 0u) ? 1u : 0u; mine = (j == x) ? c : mine; }
        if (sum == G) break;
        __builtin_amdgcn_s_sleep(1);
        if ((++sp & 255u) == 0u) { if (xb_ld(&bar[XB_TMO])) break; if (sp > XB_SPIN_CAP) { atomicAdd(&bar[XB_TMO], 1u); break; } }
    }
    nloc = mine > 0u ? mine : 1u; nx = cnt > 0u ? cnt : 1u;
}

__device__ __forceinline__ void xcd_barrier(const XcdBarrier& b, const int tid_) {
    asm volatile("s_waitcnt vmcnt(0)" ::: "memory");
    __syncthreads();
    if (tid_ == 0) {
        unsigned* bar = b.bar;
        __builtin_amdgcn_s_waitcnt(0);
        unsigned nloc = b.st[0], nx = b.st[1];
        if (nloc == 0u) { xcd_barrier_complete(bar, b.x, nloc, nx); b.st[0] = nloc; b.st[1] = nx; }
        const unsigned old = xb_add(&bar[XB_XSUB(b.x)], 1u);
        const unsigned gen = old / nloc;
        if (old + 1u == (gen + 1u) * nloc) {
            __builtin_amdgcn_fence(__ATOMIC_RELEASE, "agent");
            asm volatile("s_waitcnt vmcnt(0)" ::: "memory");
            const unsigned og = xb_add(&bar[XB_TOP], 1u);
            const unsigned tg = og / nx;
            if (og + 1u == (tg + 1u) * nx) xb_add(&bar[XB_TOPGEN], 1u);
            else XB_SPIN(xb_ld(&bar[XB_TOPGEN]) == tg, bar);
            __builtin_amdgcn_fence(__ATOMIC_ACQUIRE, "agent");
            xb_add(&bar[XB_XGEN(b.x)], 1u);
            asm volatile("s_waitcnt vmcnt(0)" ::: "memory");
        } else {
            XB_SPIN(xb_ld(&bar[XB_XGEN(b.x)]) == gen, bar);
            __builtin_amdgcn_fence(__ATOMIC_ACQUIRE, "agent");
            asm volatile("s_waitcnt vmcnt(0)" ::: "memory");
        }
    }
    __syncthreads();
}

namespace pg8 {
struct EpiF32 {
    static constexpr bool PERM = false, AFTER_DRAIN = false;
    float* O; int ldc;
    __device__ __forceinline__ void operator()(const f32x4 (&acc)[2][2][4][2], const Unit& u, int wr, int wc, int fr, int fq) const {
        const int row0 = u.pm * BM + wr * 64 + fr, col0 = u.pn * BM + wc * 32 + 4 * fq;
#pragma unroll
        for (int ai = 0; ai < 2; ++ai)
#pragma unroll
            for (int m = 0; m < 4; ++m) { float* rowp = O + (size_t)(row0 + ai * HALF + m * 16) * ldc + col0;
#pragma unroll
                for (int bj = 0; bj < 2; ++bj)
#pragma unroll
                    for (int n = 0; n < 2; ++n) *(f32x4*)(rowp + bj * HALF + n * 16) = acc[ai][bj][m][n]; }
    }
};
__device__ __forceinline__ float silu_f(float x) { return x * __builtin_amdgcn_rcpf(1.0f + __expf(-x)); }
struct EpiSwiGLU {
    static constexpr bool PERM = true, AFTER_DRAIN = false;
    bf16_t* O; int ldc;
    __device__ __forceinline__ void operator()(const f32x4 (&acc)[2][2][4][2], const Unit& u, int wr, int wc, int fr, int fq) const {
        const int row0 = u.pm * BM + wr * 64 + fr, col0 = u.pn * HALF + wc * 32 + 8 * fq;
#pragma unroll
        for (int ai = 0; ai < 2; ++ai)
#pragma unroll
            for (int m = 0; m < 4; ++m) { bf16_t* rowp = O + (size_t)(row0 + ai * HALF + m * 16) * ldc + col0;
                const f32x4 a0 = acc[ai][0][m][0], a1 = acc[ai][0][m][1], b0 = acc[ai][1][m][0], b1 = acc[ai][1][m][1];
                u32x4 w; w.x = cvt_pk_bf16(silu_f(a0[0]) * b0[0], silu_f(a0[1]) * b0[1]); w.y = cvt_pk_bf16(silu_f(a0[2]) * b0[2], silu_f(a0[3]) * b0[3]);
                w.z = cvt_pk_bf16(silu_f(a1[0]) * b1[0], silu_f(a1[1]) * b1[1]); w.w = cvt_pk_bf16(silu_f(a1[2]) * b1[2], silu_f(a1[3]) * b1[3]);
                *(u32x4*)rowp = w; }
    }
};
struct EpiP {
    static constexpr bool PERM = true, AFTER_DRAIN = false;
    bf16_t* Pm; bf16_t* Phy; int ldp; int mrows;
    __device__ __forceinline__ void operator()(const f32x4 (&acc)[2][2][4][2], const Unit& u, int wr, int wc, int fr, int fq) const {
        const int row0 = u.pm * BM + wr * 64 + fr; const int col0 = u.pn * BM + wc * 32 + 8 * fq;
        if (u.pn < 3) {
#pragma unroll
            for (int bj = 0; bj < 2; ++bj)
#pragma unroll
                for (int n = 0; n < 2; ++n) { const int hcol = col0 + bj * HALF + 4 * n, cb = hcol / 12, j0 = hcol - cb * 12;
                    bf16_t* base = Phy + ((size_t)cb * mrows + row0) * 12 + j0;
#pragma unroll
                    for (int ai = 0; ai < 2; ++ai)
#pragma unroll
                        for (int m = 0; m < 4; ++m) { const f32x4 v = acc[ai][bj][m][n];
                            const unsigned long long w = (unsigned long long)cvt_pk_bf16(v[0], v[1]) | ((unsigned long long)cvt_pk_bf16(v[2], v[3]) << 32);
                            *(unsigned long long*)(base + (size_t)(ai * HALF + m * 16) * 12) = w; } }
        } else {
#pragma unroll
            for (int ai = 0; ai < 2; ++ai)
#pragma unroll
                for (int m = 0; m < 4; ++m) { bf16_t* rowp = Pm + (size_t)(row0 + ai * HALF + m * 16) * ldp + (col0 - 768);
#pragma unroll
                    for (int bj = 0; bj < 2; ++bj) { const f32x4 v0 = acc[ai][bj][m][0], v1 = acc[ai][bj][m][1];
                        u32x4 w; w.x = cvt_pk_bf16(v0[0], v0[1]); w.y = cvt_pk_bf16(v0[2], v0[3]); w.z = cvt_pk_bf16(v1[0], v1[1]); w.w = cvt_pk_bf16(v1[2], v1[3]);
                        *(u32x4*)(rowp + bj * HALF) = w; } }
        }
    }
};

struct PanelRms {
    float* xbuf;
    unsigned* cnt;
    unsigned* tmo;
    float eps;
    __device__ __forceinline__ bool run(const f32x4 (&v)[2][2][4][2], const Unit& u, int wr, int wc, int fr, int fq, PG8_LAS unsigned char* lds, int wid, int lane) const {
        PG8_LAS float* P = (PG8_LAS float*)lds;
        PG8_LAS float* S = (PG8_LAS float*)(lds + 8192);
        PG8_LAS unsigned* flag = (PG8_LAS unsigned*)(lds + 8192 + 1024);
#pragma unroll
        for (int ai = 0; ai < 2; ++ai)
#pragma unroll
            for (int m = 0; m < 4; ++m) { float s = 0.f;
#pragma unroll
                for (int bj = 0; bj < 2; ++bj)
#pragma unroll
                    for (int n = 0; n < 2; ++n) { const f32x4 x = v[ai][bj][m][n]; s += (x[0] * x[0] + x[1] * x[1]) + (x[2] * x[2] + x[3] * x[3]); }
                s += __shfl_xor(s, 16); s += __shfl_xor(s, 32);
                if (fq == 0) P[(ai * HALF + wr * 64 + m * 16 + fr) * 4 + wc] = s; }
        asm volatile("s_waitcnt lgkmcnt(0)" ::: "memory"); __builtin_amdgcn_s_barrier(); asm volatile("" ::: "memory");
        const int row = wid * 32 + (lane & 31);
        if (lane < 32) { const float t = (P[row * 4 + 0] + P[row * 4 + 1]) + (P[row * 4 + 2] + P[row * 4 + 3]);
            __hip_atomic_store(xbuf + ((size_t)(u.pm * BM + row) * 4 + u.pn), t, __ATOMIC_RELAXED, __HIP_MEMORY_SCOPE_AGENT); }
        asm volatile("s_waitcnt vmcnt(0)" ::: "memory");
        if (lane == 0) __hip_atomic_fetch_add(cnt + 64 * u.pm, 1u, __ATOMIC_RELAXED, __HIP_MEMORY_SCOPE_AGENT);
        if (wid == 0) {
            bool dead = false; const unsigned long long t0 = __builtin_amdgcn_s_memrealtime();
            for (;;) {
                if ((unsigned)__builtin_amdgcn_readfirstlane(__hip_atomic_load(cnt + 64 * u.pm, __ATOMIC_RELAXED, __HIP_MEMORY_SCOPE_AGENT)) >= 32u) break;
                if (__builtin_amdgcn_s_memrealtime() - t0 > 2000000ull) { if (lane == 0) __hip_atomic_store(tmo, 1u, __ATOMIC_RELAXED, __HIP_MEMORY_SCOPE_AGENT); dead = true; break; }
                __builtin_amdgcn_s_sleep(2);
            }
            __builtin_amdgcn_fence(__ATOMIC_ACQUIRE, "agent");
            if (lane == 0) flag[0] = dead ? 1u : 0u;
        }
        asm volatile("s_waitcnt vmcnt(0) lgkmcnt(0)" ::: "memory"); __builtin_amdgcn_s_barrier(); asm volatile("" ::: "memory");
        const bool bad = flag[0] != 0u;
        if (lane < 32) { const float* slot = xbuf + (size_t)(u.pm * BM + row) * 4; float t = 0.f;
#pragma unroll
            for (int k = 0; k < 4; ++k) t += __hip_atomic_load(slot + k, __ATOMIC_RELAXED, __HIP_MEMORY_SCOPE_AGENT);
            S[row] = 1.0f / sqrtf(t * (1.0f / 1024.0f) + eps); }
        asm volatile("s_waitcnt lgkmcnt(0)" ::: "memory"); __builtin_amdgcn_s_barrier(); asm volatile("" ::: "memory");
        return bad;
    }
};
template <bool HAS_H, bool XB_IN, bool XB_OUT> struct EpiRes {
    static constexpr bool PERM = false, AFTER_DRAIN = true;
    const void* xprev_c; const void* xprev_s;
    void* xout; bf16_t* hout;
    const float* mod;
    const float* modh;
    int gate_off, sh_off;
    const float* gpost; const float* gpre;
    PanelRms st1, st2;
    __device__ __forceinline__ void fused(f32x4 (&acc)[2][2][4][2], const Unit& u, int wr, int wc, int fr, int fq, PG8_LAS unsigned char* lds, int wid, int lane) const {
        typedef unsigned u32x2v __attribute__((ext_vector_type(2)));
        const PG8_LAS float* S = (const PG8_LAS float*)(lds + 8192);
        const int col0 = u.pn * BM + wc * 32 + 4 * fq;
        const int cv = u.pm < 32 ? 0 : 1 + ((u.pm - 32) >> 2);
        const size_t prow = (size_t)(u.pm < 32 ? u.pm : u.pm - 32) * BM * 1024;
        const void* xpv = u.pm < 32 ? xprev_c : xprev_s;
        bool bad = st1.run(acc, u, wr, wc, fr, fq, lds, wid, lane);
        float sr[2][4];
#pragma unroll
        for (int ai = 0; ai < 2; ++ai)
#pragma unroll
            for (int m = 0; m < 4; ++m) sr[ai][m] = S[ai * HALF + wr * 64 + m * 16 + fr];
        const size_t roff = (size_t)(wr * 64 + fr) * 1024 + col0;
#pragma unroll
        for (int bj = 0; bj < 2; ++bj) {
            f32x4 gg[2];
#pragma unroll
            for (int n = 0; n < 2; ++n) { const int c = bj * HALF + n * 16; gg[n] = *(const f32x4*)(mod + (size_t)cv * 6144 + gate_off + col0 + c) * *(const f32x4*)(gpost + col0 + c); }
            if (XB_IN) {
                u32x2v bs[2][2][4];
#pragma unroll
                for (int n = 0; n < 2; ++n)
#pragma unroll
                    for (int ai = 0; ai < 2; ++ai)
#pragma unroll
                        for (int m = 0; m < 4; ++m) bs[n][ai][m] = *(const u32x2v*)((const bf16_t*)xpv + prow + roff + (size_t)(ai * HALF + m * 16) * 1024 + bj * HALF + n * 16);
#pragma unroll
                for (int n = 0; n < 2; ++n)
#pragma unroll
                    for (int ai = 0; ai < 2; ++ai)
#pragma unroll
                        for (int m = 0; m < 4; ++m) { const u32x2v b = bs[n][ai][m]; const f32x4 xv = (f32x4){__uint_as_float(b.x << 16), __uint_as_float(b.x & 0xffff0000u), __uint_as_float(b.y << 16), __uint_as_float(b.y & 0xffff0000u)};
                            acc[ai][bj][m][n] = xv + gg[n] * (acc[ai][bj][m][n] * sr[ai][m]); }
            } else {
#pragma unroll
                for (int n = 0; n < 2; ++n)
#pragma unroll
                    for (int ai = 0; ai < 2; ++ai) { f32x4 bs[4];
#pragma unroll
                        for (int m = 0; m < 4; ++m) bs[m] = *(const f32x4*)((const float*)xpv + prow + roff + (size_t)(ai * HALF + m * 16) * 1024 + bj * HALF + n * 16);
#pragma unroll
                        for (int m = 0; m < 4; ++m) acc[ai][bj][m][n] = bs[m] + gg[n] * (acc[ai][bj][m][n] * sr[ai][m]);
                        asm volatile("" : "+v"(acc[ai][bj][0][n]), "+v"(acc[ai][bj][1][n]), "+v"(acc[ai][bj][2][n]), "+v"(acc[ai][bj][3][n]));
                        asm volatile("" ::: "memory"); }
            }
            asm volatile("" : "+v"(acc[0][bj][0][0]), "+v"(acc[0][bj][1][0]), "+v"(acc[0][bj][2][0]), "+v"(acc[0][bj][3][0]), "+v"(acc[1][bj][0][0]), "+v"(acc[1][bj][1][0]), "+v"(acc[1][bj][2][0]), "+v"(acc[1][bj][3][0]));
            asm volatile("" : "+v"(acc[0][bj][0][1]), "+v"(acc[0][bj][1][1]), "+v"(acc[0][bj][2][1]), "+v"(acc[0][bj][3][1]), "+v"(acc[1][bj][0][1]), "+v"(acc[1][bj][1][1]), "+v"(acc[1][bj][2][1]), "+v"(acc[1][bj][3][1]));
            asm volatile("" ::: "memory");
        }
        const size_t orow = (size_t)(u.pm * BM) * 1024;
        if (HAS_H) {
            bad = st2.run(acc, u, wr, wc, fr, fq, lds, wid, lane) || bad;
#pragma unroll
            for (int ai = 0; ai < 2; ++ai)
#pragma unroll
                for (int m = 0; m < 4; ++m) sr[ai][m] = S[ai * HALF + wr * 64 + m * 16 + fr];
        }
#pragma unroll
        for (int bj = 0; bj < 2; ++bj)
#pragma unroll
            for (int n = 0; n < 2; ++n) { const int c = bj * HALF + n * 16;
                f32x4 sh = (f32x4){0.f, 0.f, 0.f, 0.f}, ga = sh;
                if (HAS_H) { sh = *(const f32x4*)(modh + (size_t)cv * 6144 + sh_off + col0 + c); ga = *(const f32x4*)(gpre + col0 + c) * (*(const f32x4*)(modh + (size_t)cv * 6144 + sh_off + 1024 + col0 + c) + 1.0f); }
#pragma unroll
                for (int ai = 0; ai < 2; ++ai)
#pragma unroll
                    for (int m = 0; m < 4; ++m) { const size_t off = orow + roff + (size_t)(ai * HALF + m * 16) * 1024 + c; const f32x4 x1 = acc[ai][bj][m][n];
                        if (XB_OUT) { u32x2v w; w.x = cvt_pk_bf16(x1[0], x1[1]); w.y = cvt_pk_bf16(x1[2], x1[3]); *(u32x2v*)((bf16_t*)xout + off) = w; }
                        else *(f32x4*)((float*)xout + off) = x1;
                        if (HAS_H) { const f32x4 o = (x1 * sr[ai][m]) * ga + sh; u32x2v w; w.x = cvt_pk_bf16(o[0], o[1]); w.y = cvt_pk_bf16(o[2], o[3]);
                            if (bad) { w.x = 0x7fc07fc0u; w.y = 0x7fc07fc0u; } *(u32x2v*)(hout + off) = w; } }
                asm volatile("" ::: "memory"); }
    }
};
}

constexpr int NWAVES = 8;
constexpr int NTHREADS = NWAVES * 64;
#ifndef PROBE_KIND
#define PROBE_KIND -1
#endif
#ifndef GLA_REP_A
#define GLA_REP_A 1
#endif
#ifndef GLA_REP_B
#define GLA_REP_B 1
#endif
#ifndef MK_PER_PHASE
#define MK_PER_PHASE 0
#endif
constexpr int D = 1024, NCTX = 8192, NSMP = 2048, M = NCTX + NSMP, DEPTH = 2;
constexpr int LC = 256, LS = 1024, NB_C = 32, NB_S = 2, GRIDW = 64;
constexpr int INC = 2848, INP = 3072, FF = 2816;
constexpr int LDP = 2304;
constexpr int OA = 0, OCc = 768, OBc = 1280;
constexpr float EPS = 1e-6f;
constexpr int NPHASE = 1 + 7 * DEPTH;

constexpr size_t MiB = 1u << 20;
constexpr size_t WS_CTL = 0, CTL_ZERO_BYTES = 1 * MiB;
constexpr size_t WS_MOD = 1 * MiB;
constexpr size_t WS_FILT = 2 * MiB;
constexpr size_t FILT_LAYER = 5 * MiB, FILT_S_OFF = 1 * MiB;
constexpr size_t WS_W = 12 * MiB, W_LAYER = 25 * MiB;
constexpr size_t W_IN = 0, W_OUT = 6 * MiB, W_13 = 8 * MiB, W_2 = 19 * MiB;
constexpr size_t WS_H = 62 * MiB;
constexpr size_t WS_P = 82 * MiB;
constexpr size_t WS_PHY = WS_P + 45 * MiB;
constexpr size_t WS_MIX = WS_H;
constexpr size_t WS_TBL = 202 * MiB, TBL_LAYER = 20 * MiB, TBL_S_OFF = 4 * MiB;
constexpr size_t WS_XB = 142 * MiB, WS_MF = 162 * MiB;
constexpr size_t WS_OF = 182 * MiB, WS_OB = 192 * MiB;
constexpr size_t WS_AGG = 242 * MiB;
constexpr size_t WS_XCH = 244 * MiB;
constexpr size_t XCH_BYTES = (size_t)M * 4 * 4;
constexpr size_t WS_END = 246 * MiB;
constexpr int CW_TMO = 0, CW_CODE = 1, CW_BAR = 4096, CW_GLAF = 65536, CW_MODRDY = 256, CW_SEAM = 16384, SEAM_BANK = 40 * 64;

constexpr int RING_OFF = 0, RING_BYTES = 131072;
constexpr int LDSCTL_OFF = RING_BYTES, MISC_OFF = LDSCTL_OFF + 320;
constexpr int LDS_BYTES = 163840;

struct Args { const float* in[32]; float* out; unsigned char* ws; int ph_lo, ph_hi, li, pad; };

__device__ __forceinline__ float bf2f(bf16 b) { return __uint_as_float((unsigned)b << 16); }
__device__ __forceinline__ float gelu_tanh(float x) { const float u = 0.7978845608028654f * (x + 0.044715f * x * x * x); return 0.5f * x * (1.0f + tanhf(u)); }
__device__ __forceinline__ float gelu_fast(float x) { const float u = 1.5957691216057308f * (x + 0.044715f * x * x * x); return x * __builtin_amdgcn_rcpf(1.0f + __expf(-u)); }
__device__ __forceinline__ float silu_fast(float x) { return x * __builtin_amdgcn_rcpf(1.0f + __expf(-x)); }
__device__ __forceinline__ float silu_acc(float x) { return x / (1.0f + expf(-x)); }
__device__ __forceinline__ float logsigmoid_f(float x) { return fminf(x, 0.f) - log1pf(expf(-fabsf(x))); }
__device__ __forceinline__ bf16x8 pack8(const float (&v)[8]) { v4u w; w.x = pk2(v[0], v[1]); w.y = pk2(v[2], v[3]); w.z = pk2(v[4], v[5]); w.w = pk2(v[6], v[7]); return __builtin_bit_cast(bf16x8, w); }
__device__ __forceinline__ float wave_sum(float v) {
#pragma unroll
    for (int o = 1; o < 64; o <<= 1) v += __shfl_xor(v, o);
    return v;
}

typedef float f32x4u __attribute__((ext_vector_type(4), aligned(4)));

#ifndef PROBE_T
#define PROBE_T -1
#endif
#ifndef PROBE_WG
#define PROBE_WG 40
#endif
#ifndef PROBE_K
#define PROBE_K 20
#endif
constexpr int CW_PT0 = 128, CW_PACC = 192;
__device__ __forceinline__ void probe_mark(unsigned char* ws, int id, bool begin, int wave, int lane_any) {
#if PROBE_T >= 0
    if (id == PROBE_T && (int)blockIdx.x == PROBE_WG && wave == 0) {
        const unsigned long long now = __builtin_amdgcn_s_memrealtime();
        if (__builtin_amdgcn_mbcnt_hi(~0u, __builtin_amdgcn_mbcnt_lo(~0u, 0u)) == 0u) {
            volatile unsigned long long* t0 = (volatile unsigned long long*)(ws + WS_CTL + CW_PT0 * 4); volatile unsigned long long* acc = (volatile unsigned long long*)(ws + WS_CTL + CW_PACC * 4);
            if (begin) *t0 = now; else *acc = *acc + (now - *t0); }
    }
#endif
}
__device__ __forceinline__ void probe_stretch(unsigned char* ws, int wave) {
#if PROBE_T >= 0
    if ((int)blockIdx.x == PROBE_WG && wave == 0) {
        volatile unsigned long long* acc = (volatile unsigned long long*)(ws + WS_CTL + CW_PACC * 4);
        const unsigned long long d = *acc * (unsigned long long)PROBE_K; const unsigned long long t0 = __builtin_amdgcn_s_memrealtime();
        while (__builtin_amdgcn_s_memrealtime() - t0 < d) __builtin_amdgcn_s_sleep(8);
    }
#endif
}
#define PMARK(id, b) probe_mark(a.ws, id, b, wave, 0)
#define LDS_BARRIER() do { asm volatile("s_waitcnt lgkmcnt(0)" ::: "memory"); __builtin_amdgcn_s_barrier(); asm volatile("" ::: "memory"); } while (0)
template <bool HYMAP = false>
__device__ __forceinline__ void p0_transpose_item(const float* W, int K, int N, bf16* WT, int k0, int n0, int drow0, LAS float* scr, int lane, int ch0 = 0) {
#pragma unroll 8
    for (int i = 0; i < 32; ++i) { const int kk = 2 * i + (lane >> 5); scr[kk * 33 + (lane & 31)] = W[(size_t)(k0 + kk) * N + n0 + (lane & 31)]; }
    LDS_WAIT(); asm volatile("" ::: "memory");
    const int c = lane & 7;
#pragma unroll
    for (int j = 0; j < 4; ++j) { const int n = (lane >> 3) + 8 * j; const LAS float* s = scr + (8 * c) * 33 + n;
        v4u o; o.x = pk2(s[0 * 33], s[1 * 33]); o.y = pk2(s[2 * 33], s[3 * 33]); o.z = pk2(s[4 * 33], s[5 * 33]); o.w = pk2(s[6 * 33], s[7 * 33]);
        const int drow = HYMAP ? (((ch0 + n) >> 2) * 12 + drow0 + ((ch0 + n) & 3)) : (drow0 + n);
        *(GAS v4u*)(WT + (size_t)drow * K + k0 + 8 * c) = o; }
    LDS_WAIT(); asm volatile("" ::: "memory");
}

__device__ __forceinline__ void p0_filter_item(const Args& a, int l, int path, int pblk, int q, LAS unsigned char* lds, int wave, int lane, int tid) {
    const int L = path ? LS : LC;
    float* T = (float*)(a.ws + WS_FILT + (size_t)l * FILT_LAYER + (path ? FILT_S_OFF : 0));
    const float* w1 = a.in[20] + (size_t)l * 17 * 64; const float* b1 = a.in[21] + l * 64; const float* fr = a.in[22] + l * 64;
    const float* w2 = a.in[23] + (size_t)l * 64 * 64; const float* b2 = a.in[24] + l * 64; const float* w3 = a.in[25] + (size_t)l * 64 * 1024;
    const float* ld = a.in[26] + (size_t)l * 1024; const float* hb = a.in[27] + (size_t)l * 512;
    LAS float* W3s = (LAS float*)lds;
    LAS float* scr = (LAS float*)(lds + 65536 + wave * 2048);
    LAS float* feat = scr;
    LAS float* h1 = scr + 80;
    LAS float* h2 = scr + 80 + 256;
    float w1v[17]; const float frq = fr[lane], bb1 = b1[lane], bb2 = b2[lane];
    {   f32x4 wv[8];
#pragma unroll
        for (int j = 0; j < 8; ++j) { const int u = tid + NTHREADS * j, i = u >> 6, c4 = u & 63; wv[j] = *(const GAS f32x4*)(w3 + (size_t)i * 1024 + q * 256 + 4 * c4); }
#pragma unroll
        for (int f = 0; f < 17; ++f) w1v[f] = w1[f * 64 + lane];
#pragma unroll
        for (int j = 0; j < 8; ++j) { const int u = tid + NTHREADS * j; *(LAS f32x4*)(W3s + 4 * u) = wv[j]; }
    }
    const int pb = pblk * 8 + wave;
    const float TWO_PI = 6.283185307179586f;
    if (lane < 17) {
#pragma unroll
        for (int p = 0; p < 4; ++p) { const int pos = pb * 4 + p; const float t = (float)pos / (float)(L - 1); const float om = TWO_PI * (float)pos / (float)L;
            float v;
            if (lane == 0) v = t;
            else { const int bi = (lane - 1) & 7; const float band = 1e-4f + (float)bi * ((7.0f - 1e-4f) / 7.0f); v = (lane <= 8) ? cosf(om * band) : sinf(om * band); }
            feat[p * 20 + lane] = v; }
    }
    LDS_WAIT(); asm volatile("" ::: "memory");
    {   float acc[4];
#pragma unroll
        for (int p = 0; p < 4; ++p) acc[p] = bb1;
#pragma unroll
        for (int f = 0; f < 17; ++f) {
#pragma unroll
            for (int p = 0; p < 4; ++p) acc[p] += feat[p * 20 + f] * w1v[f]; }
#pragma unroll
        for (int p = 0; p < 4; ++p) h1[p * 64 + lane] = sinf(frq * acc[p]);
    }
    LDS_WAIT(); asm volatile("" ::: "memory");
    {   float acc[4];
#pragma unroll
        for (int p = 0; p < 4; ++p) acc[p] = bb2;
#pragma unroll 1
        for (int i0 = 0; i0 < 64; i0 += 32) { float wv[32];
#pragma unroll
            for (int i = 0; i < 32; ++i) wv[i] = w2[(i0 + i) * 64 + lane];
#pragma unroll
            for (int i = 0; i < 32; ++i)
#pragma unroll
                for (int p = 0; p < 4; ++p) acc[p] += h1[p * 64 + i0 + i] * wv[i]; }
#pragma unroll
        for (int p = 0; p < 4; ++p) h2[p * 64 + lane] = sinf(frq * acc[p]);
    }
    __syncthreads();
    {   f32x4 acc[4];
#pragma unroll
        for (int p = 0; p < 4; ++p) acc[p] = (f32x4){0.f, 0.f, 0.f, 0.f};
#pragma unroll 8
        for (int i = 0; i < 64; ++i) { const f32x4 w = *(const LAS f32x4*)(W3s + i * 256 + 4 * lane);
#pragma unroll
            for (int p = 0; p < 4; ++p) acc[p] += w * h2[p * 64 + i]; }
        const int dir = q >> 1, o = q & 1;
        const f32x4 ldv = *(const f32x4*)(ld + q * 256 + 4 * lane);
        const f32x4 bv = *(const f32x4*)(hb + o * 256 + 4 * lane);
#pragma unroll
        for (int e = 0; e < 4; ++e) { const float rate = expf(ldv[e]); float v[4];
#pragma unroll
            for (int p = 0; p < 4; ++p) { const int pos = pb * 4 + p; const float t = (float)pos / (float)(L - 1); v[p] = acc[p][e] * expf(-rate * t); }
            float* row = T + ((size_t)(o * 256 + 4 * lane + e)) * (2 * L);
            if (dir == 0) { if (pb == 0) { v[0] += bv[e]; row[0] = 0.f; }
                *(f32x4u*)(row + L - 4 * pb - 3) = (f32x4u){v[3], v[2], v[1], v[0]}; }
            else { if (pb == 0) { row[L + 1] = v[1]; row[L + 2] = v[2]; row[L + 3] = v[3]; } else *(f32x4*)(row + L + 4 * pb) = (f32x4){v[0], v[1], v[2], v[3]}; } }
    }
    __syncthreads();
}

__device__ __forceinline__ void p0_mod_item(const Args& a, int l, int cb, LAS float* sv  , LAS float* red  , int wave, int lane, int tid) {
    const float* wm = a.in[5] + (size_t)l * D * 6144; const float* bm = a.in[6] + (size_t)l * 6144;
    float* mod = (float*)(a.ws + WS_MOD) + (size_t)l * 3 * 6144;
    const int j0 = cb * 64 + 4 * (lane & 15), ks = lane >> 4;
    f32x4 wv[32];
#pragma unroll
    for (int i = 0; i < 32; ++i) wv[i] = *(const GAS f32x4*)(wm + (size_t)(wave * 128 + i * 4 + ks) * 6144 + j0);
    for (int i = tid; i < 3 * 1024; i += NTHREADS) { const int c = i >> 10, k = i & 1023; const float v = (c == 0) ? a.in[4][k] : a.in[3][(c - 1) * 1024 + k]; sv[i] = silu_acc(v); }
    __syncthreads();
    f32x4 acc[3];
#pragma unroll
    for (int c = 0; c < 3; ++c) acc[c] = (f32x4){0.f, 0.f, 0.f, 0.f};
#pragma unroll
    for (int i = 0; i < 32; ++i) { const int k = wave * 128 + i * 4 + ks;
#pragma unroll
        for (int c = 0; c < 3; ++c) acc[c] += wv[i] * sv[c * 1024 + k]; }
#pragma unroll
    for (int c = 0; c < 3; ++c)
#pragma unroll
        for (int e = 0; e < 4; ++e) { float v = acc[c][e]; v += __shfl_xor(v, 16); v += __shfl_xor(v, 32); acc[c][e] = v; }
    if (lane < 16) {
#pragma unroll
        for (int c = 0; c < 3; ++c)
#pragma unroll
            for (int e = 0; e < 4; ++e) red[(wave * 3 + c) * 64 + 4 * lane + e] = acc[c][e];
    }
    __syncthreads();
    if (tid < 192) { const int c = tid >> 6, j = tid & 63; float s = bm[cb * 64 + j];
#pragma unroll
        for (int w = 0; w < 8; ++w) s += red[(w * 3 + c) * 64 + j];
        const int col = cb * 64 + j, blk = col >> 10, k = col & 1023;
        if (blk == 1) s = (1.0f + s) * a.in[7][l * D + k]; else if (blk == 2) s *= a.in[8][l * D + k]; else if (blk == 4) s = (1.0f + s) * a.in[9][l * D + k]; else if (blk == 5) s *= a.in[10][l * D + k];
        mod[c * 6144 + col] = s; }
    __syncthreads();
}

constexpr int I_IN = 16 * 89, I_PAD = 224, I_OUT = 16 * 32, I_1 = 16 * 88, I_2 = 44 * 32;
constexpr int C_IN = I_IN + I_PAD, C_OUT = C_IN + I_OUT, C_13 = C_OUT + 2 * I_1, C_2 = C_13 + I_2;
__device__ __forceinline__ void convert_items(const Args& a, int l, int lo, int hi, int worker, int nworkers, LAS float* scr, int lane) {
    unsigned char* wl = a.ws + WS_W + (size_t)l * W_LAYER;
    for (int it = lo + worker; it < hi; it += nworkers) { int r = it;
        if (r < I_IN) { const int kb = r / 89, nb = r % 89, n0 = 32 * nb; const float* W = a.in[11] + (size_t)l * D * INC; bf16* WT = (bf16*)(wl + W_IN);
            if (n0 < 768) p0_transpose_item(W, D, INC, WT, 64 * kb, n0, 768 + n0, scr, lane);
            else if (n0 < 1568) p0_transpose_item(W, D, INC, WT, 64 * kb, n0, 2048 + (n0 - 768), scr, lane);
            else if (n0 < 2080) p0_transpose_item(W, D, INC, WT, 64 * kb, n0, 1536 + (n0 - 1568), scr, lane);
            else { const int cp = n0 - 2080; p0_transpose_item<true>(W, D, INC, WT, 64 * kb, n0, (cp >> 8) * 4, scr, lane, cp & 255); }
            continue; } r -= I_IN;
        if (r < I_PAD) { GAS v4u* dst = (GAS v4u*)((bf16*)(wl + W_IN) + (size_t)(INC + r) * D) + lane * 2; dst[0] = (v4u){0u, 0u, 0u, 0u}; dst[1] = (v4u){0u, 0u, 0u, 0u}; continue; } r -= I_PAD;
        if (r < I_OUT) { const int kb = r / 32, nb = r % 32; p0_transpose_item(a.in[28] + (size_t)l * D * D, D, D, (bf16*)(wl + W_OUT), 64 * kb, 32 * nb, 32 * nb, scr, lane); continue; } r -= I_OUT;
        if (r < I_1) { const int kb = r / 88, nb = r % 88, n0 = 32 * nb; p0_transpose_item(a.in[29] + (size_t)l * D * FF, D, FF, (bf16*)(wl + W_13), 64 * kb, n0, (n0 >> 7) * 256 + (n0 & 127), scr, lane); continue; } r -= I_1;
        if (r < I_1) { const int kb = r / 88, nb = r % 88, n0 = 32 * nb; p0_transpose_item(a.in[30] + (size_t)l * D * FF, D, FF, (bf16*)(wl + W_13), 64 * kb, n0, (n0 >> 7) * 256 + 128 + (n0 & 127), scr, lane); continue; } r -= I_1;
        { const int kb = r / 32, nb = r % 32; p0_transpose_item(a.in[31] + (size_t)l * FF * D, FF, D, (bf16*)(wl + W_2), 64 * kb, 32 * nb, 32 * nb, scr, lane); }
    }
}

__device__ __forceinline__ void row_phase(const Args& a, int l, int mode, int vcu, int G, int wave, int lane);
__device__ __forceinline__ void p0_prologue(const Args& a, LAS unsigned char* lds, int vcu, int G, int wave, int lane, int tid) {
    LAS float* scr = (LAS float*)(lds + RING_OFF + wave * 16384);
    PMARK(50, true);
    {
        LAS float* sv = (LAS float*)(lds + RING_OFF);
        LAS float* red = (LAS float*)(lds + RING_OFF + 12288);
        for (int it = vcu; it < 96; it += G) {
            p0_mod_item(a, 0, it, sv, red, wave, lane, tid);
            if (it < 32) {
                asm volatile("s_waitcnt vmcnt(0)" ::: "memory"); __syncthreads();
                if (tid == 0) { __builtin_amdgcn_fence(__ATOMIC_RELEASE, "agent"); asm volatile("s_waitcnt vmcnt(0)" ::: "memory"); __hip_atomic_fetch_add((gu32*)(a.ws + WS_CTL) + CW_MODRDY, 1u, __ATOMIC_RELAXED, __HIP_MEMORY_SCOPE_AGENT); } }
        }
        __syncthreads();
    }
    PMARK(50, false); PMARK(51, true);
    const int gw = vcu * NWAVES + wave, NGW = G * NWAVES;
    for (int it = vcu - 96; it >= 0 && it < 160; it += G) { const int blk = it >> 2, q = it & 3; if (blk < 32) p0_filter_item(a, 0, 1, blk, q, lds, wave, lane, tid); else p0_filter_item(a, 0, 0, blk - 32, q, lds, wave, lane, tid); }
    PMARK(51, false); PMARK(52, true);
    convert_items(a, 0, 0, C_OUT, gw, NGW, scr, lane);
    PMARK(52, false); PMARK(53, true);
    if (wave == 0) { unsigned sp = 0;
        while (__hip_atomic_load((gu32*)(a.ws + WS_CTL) + CW_MODRDY, __ATOMIC_RELAXED, __HIP_MEMORY_SCOPE_AGENT) < 32u) { __builtin_amdgcn_s_sleep(2);
            if (++sp > (1u << 20)) { if (lane == 0) __hip_atomic_store((gu32*)(a.ws + WS_CTL) + CW_TMO, 1u, __ATOMIC_RELAXED, __HIP_MEMORY_SCOPE_AGENT); break; } }
        __builtin_amdgcn_fence(__ATOMIC_ACQUIRE, "agent"); asm volatile("s_waitcnt vmcnt(0)" ::: "memory"); }
    __syncthreads();
    row_phase(a, 0, 0, vcu, G, wave, lane);
    PMARK(53, false);
}

__device__ __forceinline__ void late_mod_item(const Args& a, int item, LAS unsigned char* lds, int wave, int lane, int tid) {
    p0_mod_item(a, 1, item, (LAS float*)(lds + RING_OFF), (LAS float*)(lds + RING_OFF + 12288), wave, lane, tid); }
__device__ __forceinline__ void late_filter_item(const Args& a, int it, LAS unsigned char* lds, int wave, int lane, int tid) {
    const int blk = it >> 2, q = it & 3; if (blk < 32) p0_filter_item(a, 1, 1, blk, q, lds, wave, lane, tid); else p0_filter_item(a, 1, 0, blk - 32, q, lds, wave, lane, tid); }
__device__ __forceinline__ void unpack8(const bf16x8 v, float (&o)[8]) {
#pragma unroll
    for (int e = 0; e < 8; ++e) o[e] = bf2f((bf16)v[e]);
}
__device__ __forceinline__ void row_phase(const Args& a, int l, int mode, int vcu, int G, int wave, int lane) {
    const int gw = vcu * NWAVES + wave, NGW = G * NWAVES;
    const bf16* MB = (const bf16*)(a.ws + WS_MF); bf16* XB = (bf16*)(a.ws + WS_XB); bf16* H = (bf16*)(a.ws + WS_H);
    const float* modb = (const float*)(a.ws + WS_MOD);
    const bool has_h = !(mode == 2 && l == DEPTH - 1);
    const bool x_in_f32 = (mode == 0) || (mode == 1 && l == 0);
    const bool x_out_f32 = (mode == 2 && l == DEPTH - 1);
    const int lh = (mode == 2) ? l + 1 : l;
    const int gate_blk = (mode == 1) ? 2 : 5, sh_blk = (mode == 1) ? 3 : 0;
#pragma unroll 1
    for (int r0 = gw; r0 < M; r0 += 2 * NGW) {
        int rr[2]; bool ok[2]; rr[0] = r0; rr[1] = r0 + NGW; ok[0] = true; ok[1] = rr[1] < M; if (!ok[1]) rr[1] = r0;
        float x[2][2][8]; bf16x8 mraw[2][2]; f32x4 gt[2][4], ga[2][4], sh[2][4];
#pragma unroll
        for (int q = 0; q < 2; ++q) { const int r = rr[q]; const int cv = (r < NCTX) ? 0 : 1 + ((r - NCTX) >> 10);
            if (mode != 0) {
#pragma unroll
                for (int j = 0; j < 2; ++j) mraw[q][j] = *(const GAS bf16x8*)(MB + (size_t)r * D + 512 * j + 8 * lane); }
            if (x_in_f32) { const float* xp = (r < NCTX) ? a.in[0] + (size_t)r * D : a.in[1] + (size_t)(r - NCTX) * D;
#pragma unroll
                for (int j = 0; j < 2; ++j) { const f32x4 v0 = *(const GAS f32x4*)(xp + 512 * j + 8 * lane), v1 = *(const GAS f32x4*)(xp + 512 * j + 8 * lane + 4);
#pragma unroll
                    for (int e = 0; e < 4; ++e) { x[q][j][e] = v0[e]; x[q][j][4 + e] = v1[e]; } } }
            else {
#pragma unroll
                for (int j = 0; j < 2; ++j) { const bf16x8 xr = *(const GAS bf16x8*)(XB + (size_t)r * D + 512 * j + 8 * lane); unpack8(xr, x[q][j]); } }
            const float* mg = modb + ((size_t)l * 3 + cv) * 6144 + gate_blk * 1024; const float* mh = modb + ((size_t)(has_h ? lh : l) * 3 + cv) * 6144 + sh_blk * 1024;
#pragma unroll
            for (int j = 0; j < 2; ++j)
#pragma unroll
                for (int h4 = 0; h4 < 2; ++h4) { const int c = 512 * j + 8 * lane + 4 * h4;
                    if (mode != 0) gt[q][2 * j + h4] = *(const GAS f32x4*)(mg + c);
                    if (has_h) { sh[q][2 * j + h4] = *(const GAS f32x4*)(mh + c); ga[q][2 * j + h4] = *(const GAS f32x4*)(mh + 1024 + c); } } }
#pragma unroll
        for (int q = 0; q < 2; ++q) { const int r = rr[q];
            if (mode != 0) {
                float mv[2][8]; float s = 0.f;
#pragma unroll
                for (int j = 0; j < 2; ++j) { unpack8(mraw[q][j], mv[j]);
#pragma unroll
                    for (int e = 0; e < 8; ++e) s += mv[j][e] * mv[j][e]; }
                const float rn = __builtin_amdgcn_rsqf(wave_sum(s) * (1.0f / D) + EPS);
#pragma unroll
                for (int j = 0; j < 2; ++j)
#pragma unroll
                    for (int h4 = 0; h4 < 2; ++h4)
#pragma unroll
                        for (int e = 0; e < 4; ++e) x[q][j][4 * h4 + e] += gt[q][2 * j + h4][e] * (mv[j][4 * h4 + e] * rn);
                if (ok[q]) {
                    if (x_out_f32) {
#pragma unroll
                        for (int j = 0; j < 2; ++j) { float* op = a.out + (size_t)r * D + 512 * j + 8 * lane; *(GAS f32x4*)op = (f32x4){x[q][j][0], x[q][j][1], x[q][j][2], x[q][j][3]}; *(GAS f32x4*)(op + 4) = (f32x4){x[q][j][4], x[q][j][5], x[q][j][6], x[q][j][7]}; } }
                    else {
#pragma unroll
                        for (int j = 0; j < 2; ++j) *(GAS bf16x8*)(XB + (size_t)r * D + 512 * j + 8 * lane) = pack8(x[q][j]); } }
            }
            if (has_h) {
                float s = 0.f;
#pragma unroll
                for (int j = 0; j < 2; ++j)
#pragma unroll
                    for (int e = 0; e < 8; ++e) s += x[q][j][e] * x[q][j][e];
                const float rn = __builtin_amdgcn_rsqf(wave_sum(s) * (1.0f / D) + EPS);
                if (ok[q]) {
#pragma unroll
                    for (int j = 0; j < 2; ++j) { float hv[8];
#pragma unroll
                        for (int h4 = 0; h4 < 2; ++h4)
#pragma unroll
                            for (int e = 0; e < 4; ++e) hv[4 * h4 + e] = (x[q][j][4 * h4 + e] * rn) * ga[q][2 * j + h4][e] + sh[q][2 * j + h4][e];
                        *(GAS bf16x8*)(H + (size_t)r * D + 512 * j + 8 * lane) = pack8(hv); } }
            }
        }
    }
}

__device__ __forceinline__ void p1_table_phase(const Args& a, int vcu, int G, int wave, int lane) {
    const int gw = vcu * NWAVES + wave, NGW = G * NWAVES;
    for (int it = gw; it < DEPTH * 512 * 5; it += NGW) {
        const int path = it < DEPTH * 2048 ? 1 : 0; const int r = path ? it : it - DEPTH * 2048;
        const int l = path ? (r >> 11) : (r >> 9), oc = path ? ((r >> 2) & 511) : (r & 511), mq = path ? (r & 3) : 0;
        const int L = path ? LS : LC;
        const float* Rp = (const float*)(a.ws + WS_FILT + (size_t)l * FILT_LAYER + (path ? FILT_S_OFF : 0)) + (size_t)oc * (2 * L);
        bf16* tb = (bf16*)(a.ws + WS_TBL + (size_t)l * TBL_LAYER + (path ? TBL_S_OFF : 0)) + (size_t)oc * (16 * L);
#pragma unroll 1
        for (int i0 = 0; i0 < 8; i0 += 4) {
            f32x4u va[4], vb[4]; int mm[4], jj[4];
#pragma unroll
            for (int i = 0; i < 4; ++i) { const int task = lane + 64 * (i0 + i); mm[i] = path ? 2 * mq + (task >> 8) : (task >> 6); jj[i] = path ? (task & 255) : (task & 63);
                const int y0 = 8 * jj[i] + mm[i];
                if (y0 + 8 <= 2 * L) { va[i] = *(const f32x4u*)(Rp + y0); vb[i] = *(const f32x4u*)(Rp + y0 + 4); }
                else {
#pragma unroll
                    for (int e = 0; e < 4; ++e) { va[i][e] = (y0 + e < 2 * L) ? Rp[y0 + e] : 0.f; vb[i][e] = (y0 + 4 + e < 2 * L) ? Rp[y0 + 4 + e] : 0.f; } } }
#pragma unroll
            for (int i = 0; i < 4; ++i) { v4u o; o.x = pk2(va[i][0], va[i][1]); o.y = pk2(va[i][2], va[i][3]); o.z = pk2(vb[i][0], vb[i][1]); o.w = pk2(vb[i][2], vb[i][3]);
                *(GAS v4u*)(tb + (size_t)mm[i] * (2 * L) + 8 * jj[i]) = o; }
        }
    }
}

template <int PATH>
__device__ __forceinline__ void hyena_mfma_item(const Args& a, int l, int item, LAS unsigned char* lds, int tid, int wave) {
    constexpr int L = PATH ? LS : LC, NROW = PATH ? 2 : 16, NT = NROW * L;
    constexpr int ZLEN = PATH ? 3760 : 264, ZOFF = PATH ? 1240 : 0, XLEN = PATH ? 1024 : 264;
#define ZIDX(t) (PATH ? (ZOFF + ((t) >> 5) * 40 + ((t) & 31)) : (t))
    constexpr int Z_BYTES = 4 * NROW * ZLEN * 2, X_BYTES = 4 * NROW * XLEN * 2;
    constexpr int TBC = L * 4, TB_BYTES = 4 * 2 * TBC;
    static_assert(Z_BYTES + 2 * X_BYTES + TB_BYTES <= RING_BYTES && NT * 8 <= X_BYTES, "hyena LDS map");
    LAS unsigned* TBs = (LAS unsigned*)(lds + Z_BYTES + 2 * X_BYTES);
    LAS bf16* Zs = (LAS bf16*)lds; LAS bf16* X1s = (LAS bf16*)(lds + Z_BYTES); LAS bf16* X2s = (LAS bf16*)(lds + Z_BYTES + X_BYTES);
    LAS bf16* OUTs = X1s;
    const int cb = PATH ? item : (item & 63); const int rowbase = PATH ? NCTX : (item >> 6) * 16 * LC;
    const bf16* PH = (const bf16*)(a.ws + WS_PHY) + ((size_t)cb * M + rowbase) * 12; bf16* MIX = (bf16*)(a.ws + WS_MIX);
    const float* cw = a.in[19] + (size_t)l * 3 * 768;
    const int lane = tid & 63, r = lane & 15, qd = lane >> 4;
    PMARK(30 + 10 * PATH, true); PMARK(31 + 10 * PATH, true);
    if (PATH) {
        for (int u = tid; u < 8 * ZLEN / 8; u += NTHREADS) *(LAS v4u*)(Zs + u * 8) = (v4u){0u, 0u, 0u, 0u};
        LDS_BARRIER(); }
    {   float w0[3][4], w1[3][4], w2[3][4];
#pragma unroll
        for (int part = 0; part < 3; ++part)
#pragma unroll
            for (int cc = 0; cc < 4; ++cc) { const int col = part * 256 + 4 * cb + cc; w0[part][cc] = cw[col]; w1[part][cc] = cw[768 + col]; w2[part][cc] = cw[1536 + col]; }
        constexpr int NI = NT / NTHREADS;
#pragma unroll 1
        for (int i0 = 0; i0 < NI; i0 += 4) {
            unsigned long long cm[4][3], lm[4][3], rm[4][3];
#pragma unroll
            for (int ii = 0; ii < 4; ++ii) { const int n = tid + NTHREADS * (i0 + ii); const int t = n & (L - 1); const int wpos = PATH ? (t & (GRIDW - 1)) : t; const bool hl = wpos > 0, hr = wpos < (PATH ? GRIDW : LC) - 1;
                const bf16* p = PH + (size_t)n * 12;
#pragma unroll
                for (int part = 0; part < 3; ++part) { cm[ii][part] = *(const GAS unsigned long long*)(p + 4 * part); lm[ii][part] = hl ? *(const GAS unsigned long long*)(p - 12 + 4 * part) : 0ull; rm[ii][part] = hr ? *(const GAS unsigned long long*)(p + 12 + 4 * part) : 0ull; } }
#pragma unroll
            for (int ii = 0; ii < 4; ++ii) { const int n = tid + NTHREADS * (i0 + ii); const int bb = n / L, t = n - bb * L;
#pragma unroll
                for (int part = 0; part < 3; ++part) {
                    LAS bf16* dst = (part == 0 ? X1s : (part == 1 ? X2s : Zs)) + (size_t)bb * (part == 2 ? ZLEN : XLEN) + (part == 2 ? ZIDX(t) : t);
                    const int cstride = NROW * (part == 2 ? ZLEN : XLEN);
#pragma unroll
                    for (int cc = 0; cc < 4; ++cc) { const float v = w1[part][cc] * bf2f((bf16)(cm[ii][part] >> (16 * cc))) + w0[part][cc] * bf2f((bf16)(lm[ii][part] >> (16 * cc))) + w2[part][cc] * bf2f((bf16)(rm[ii][part] >> (16 * cc)));
                        dst[cc * cstride] = (bf16)f2bf(v); } } }
        }
    }
    LDS_BARRIER();
    PMARK(31 + 10 * PATH, false); PMARK(32 + 10 * PATH, true);
    const int cc = wave >> 1, half = wave & 1;
    const int pcopy = r & 1;
    const int lane_dw = pcopy * L + ((L - r + 8 * qd - pcopy) >> 1);
#pragma unroll 1
    for (int o = 0; o < 2; ++o) {
        PMARK(34 + 10 * PATH, true);
        {
            const float* Rp = (const float*)(a.ws + WS_FILT + (size_t)l * FILT_LAYER + (PATH ? FILT_S_OFF : 0)) + (size_t)(o * 256 + 4 * cb) * (2 * L);
            for (int u = tid; u < L; u += NTHREADS) { const int ch = u / (L / 4), j0 = 4 * (u - ch * (L / 4)); const float* rp = Rp + (size_t)ch * (2 * L) + 2 * j0;
                const f32x4 v0 = *(const GAS f32x4*)rp, v1 = *(const GAS f32x4*)(rp + 4); const float v8 = (2 * j0 + 8 < 2 * L) ? rp[8] : 0.f;
                v4u c0, c1; c0.x = pk2(v0[0], v0[1]); c0.y = pk2(v0[2], v0[3]); c0.z = pk2(v1[0], v1[1]); c0.w = pk2(v1[2], v1[3]);
                c1.x = pk2(v0[1], v0[2]); c1.y = pk2(v0[3], v1[0]); c1.z = pk2(v1[1], v1[2]); c1.w = pk2(v1[3], v8);
                *(LAS v4u*)(TBs + (ch * 2 + 0) * L + j0) = c0; *(LAS v4u*)(TBs + (ch * 2 + 1) * L + j0) = c1; }
        }
        LDS_BARRIER();
        PMARK(34 + 10 * PATH, false); PMARK(35 + 10 * PATH, true);
        const LAS unsigned* tb = TBs + cc * 2 * L + lane_dw;
        const LAS bf16* Xg = (o == 0 ? X1s : X2s) + (size_t)cc * NROW * XLEN;
        LAS bf16* Zc = Zs + (size_t)cc * NROW * ZLEN;
        if (!PATH) {
            bf16x8 afr[22];
#pragma unroll
            for (int u = 0; u < 22; ++u) { const LAS unsigned* q = tb - (128 * half + 16 * (u - 14)) / 2; v4u w; w.x = q[0]; w.y = q[1]; w.z = q[2]; w.w = q[3]; afr[u] = __builtin_bit_cast(bf16x8, w); }
            f32x4 acc[8];
#pragma unroll
            for (int tt = 0; tt < 8; ++tt) acc[tt] = (f32x4){0.f, 0.f, 0.f, 0.f};
#pragma unroll
            for (int kj = 0; kj < 8; ++kj) { const bf16x8 bfr = *(const LAS bf16x8*)(Zc + r * ZLEN + 32 * kj + 8 * qd);
#pragma unroll
                for (int tt = 0; tt < 8; ++tt) acc[tt] = __builtin_amdgcn_mfma_f32_16x16x32_bf16(afr[tt - 2 * kj + 14], bfr, acc[tt], 0, 0, 0); }
            asm volatile("" : "+v"(acc[0]), "+v"(acc[7])); PMARK(35 + 10 * PATH, false); PMARK(36 + 10 * PATH, true);
            LDS_BARRIER();
#pragma unroll
            for (int tt = 0; tt < 8; ++tt) { const int t0 = 16 * (8 * half + tt) + 4 * qd; const unsigned long long gm = *(const LAS unsigned long long*)(Xg + r * XLEN + t0);
                float v[4];
#pragma unroll
                for (int e = 0; e < 4; ++e) v[e] = bf2f((bf16)(gm >> (16 * e))) * acc[tt][e];
                if (o == 0) *(LAS unsigned long long*)(Zc + r * ZLEN + t0) = (unsigned long long)pk2(v[0], v[1]) | ((unsigned long long)pk2(v[2], v[3]) << 32);
                else {
#pragma unroll
                    for (int e = 0; e < 4; ++e) OUTs[(size_t)(r * L + t0 + e) * 4 + cc] = (bf16)f2bf(v[e]); } }
        } else {
            f32x4 acc[2][2];
#pragma unroll
            for (int pt = 0; pt < 2; ++pt)
#pragma unroll
                for (int ih = 0; ih < 2; ++ih) acc[pt][ih] = (f32x4){0.f, 0.f, 0.f, 0.f};
            const LAS bf16* Zb = Zc + half * ZLEN + (31 + r) * 40 + 8 * qd;
#define HY_STEP(d, DO0, DO1) do { const LAS unsigned* q0 = tb - (32 * (d)) / 2; v4u w0, w1; w0.x = q0[0]; w0.y = q0[1]; w0.z = q0[2]; w0.w = q0[3]; w1.x = q0[-8]; w1.y = q0[-7]; w1.z = q0[-6]; w1.w = q0[-5]; \
                const bf16x8 a0 = __builtin_bit_cast(bf16x8, w0), a1 = __builtin_bit_cast(bf16x8, w1); \
                if (DO0) { const bf16x8 b0 = *(const LAS bf16x8*)(Zb - (d) * 40); acc[0][0] = __builtin_amdgcn_mfma_f32_16x16x32_bf16(a0, b0, acc[0][0], 0, 0, 0); acc[1][0] = __builtin_amdgcn_mfma_f32_16x16x32_bf16(a1, b0, acc[1][0], 0, 0, 0); } \
                if (DO1) { const bf16x8 b1 = *(const LAS bf16x8*)(Zb + (16 - (d)) * 40); acc[0][1] = __builtin_amdgcn_mfma_f32_16x16x32_bf16(a0, b1, acc[0][1], 0, 0, 0); acc[1][1] = __builtin_amdgcn_mfma_f32_16x16x32_bf16(a1, b1, acc[1][1], 0, 0, 0); } } while (0)
#pragma unroll 2
            for (int d = -31; d <= -16; ++d) HY_STEP(d, true, false);
#pragma unroll 1
            for (int d = -15; d <= 15; ++d) HY_STEP(d, true, true);
#pragma unroll 2
            for (int d = 16; d <= 31; ++d) HY_STEP(d, false, true);
#undef HY_STEP
            asm volatile("" : "+v"(acc[0][0]), "+v"(acc[1][1])); PMARK(35 + 10 * PATH, false); PMARK(36 + 10 * PATH, true);
            LDS_BARRIER();
#pragma unroll
            for (int pt = 0; pt < 2; ++pt)
#pragma unroll
                for (int ih = 0; ih < 2; ++ih) { const int bb = half, t0 = 32 * (16 * ih + r) + 16 * pt + 4 * qd; const unsigned long long gm = *(const LAS unsigned long long*)(Xg + bb * XLEN + t0);
                    float v[4];
#pragma unroll
                    for (int e = 0; e < 4; ++e) v[e] = bf2f((bf16)(gm >> (16 * e))) * acc[pt][ih][e];
                    if (o == 0) *(LAS unsigned long long*)(Zc + bb * ZLEN + ZIDX(t0)) = (unsigned long long)pk2(v[0], v[1]) | ((unsigned long long)pk2(v[2], v[3]) << 32);
                    else {
#pragma unroll
                        for (int e = 0; e < 4; ++e) OUTs[(size_t)(bb * L + t0 + e) * 4 + cc] = (bf16)f2bf(v[e]); } }
        }
        LDS_BARRIER();
        PMARK(36 + 10 * PATH, false);
    }
    PMARK(32 + 10 * PATH, false); PMARK(33 + 10 * PATH, true);
    for (int n = tid; n < NT; n += NTHREADS) *(GAS unsigned long long*)(MIX + (size_t)(rowbase + n) * D + 768 + 4 * cb) = *(const LAS unsigned long long*)(OUTs + (size_t)n * 4);
    LDS_BARRIER();
    PMARK(33 + 10 * PATH, false); PMARK(30 + 10 * PATH, false);
#undef ZIDX
}

__device__ __forceinline__ int ba_row0(int ba) { return ba < 2 ? NCTX + ba * LS : (ba - 2) * LC; }

template <int CTRL> __device__ __forceinline__ float dpp_f(float x) { return __int_as_float(__builtin_amdgcn_update_dpp(0, __float_as_int(x), CTRL, 0xf, 0xf, true)); }
__device__ __forceinline__ float bperm_f(int src_lane, float v) { return __int_as_float(__builtin_amdgcn_ds_bpermute(src_lane << 2, __float_as_int(v))); }
__device__ __forceinline__ float row16_sum(float v) {
    v += dpp_f<0xB1>(v); v += dpp_f<0x4E>(v); v += dpp_f<0x141>(v); v += dpp_f<0x140>(v); return v; }
constexpr int GLA_SRUN_OFF = LDSCTL_OFF + 1024;
__device__ __forceinline__ float fast_logsigmoid(float x) { return fminf(x, 0.f) - __logf(1.0f + __expf(-fabsf(x))); }
__device__ __forceinline__ void gla_mfma_item(const Args& a, int l, int ba, int h, int q, LAS unsigned char* lds, int tid_item, int wave) {
    constexpr int L = 256, NC = 4, rounds = 1; const int row0 = ba_row0(ba) + 256 * q;
    const int dir = wave & 1, n = wave >> 1;
    int tid = tid_item; int lane = tid & 63, r = lane & 15, qd = lane >> 4;
    LAS unsigned char* reg = lds + wave * 16384;
    LAS bf16* VT = (LAS bf16*)reg;
    LAS float* Ureg = (LAS float*)reg;
    LAS bf16* KT = (LAS bf16*)(reg + 9216);
    LAS float* WQ = (LAS float*)(reg + 13824);
    LAS float* VTOT = (LAS float*)(reg + 15872);
    LAS float* VSC = (LAS float*)(reg + 16000);
    LAS float* SRUN = (LAS float*)(lds + GLA_SRUN_OFF);
    PMARK(1, true); PMARK(2, true);
    for (int u = tid; u < 2 * 2048; u += NTHREADS) SRUN[u] = 0.f;
    {   const float* wg = a.in[13] + ((size_t)l * 2 + dir) * 16 * 128 + h * 32; float wv[8];
#pragma unroll
        for (int i = 0; i < 8; ++i) { const int u = lane + 64 * i, q4 = u >> 7, rr = (u >> 3) & 15, e = u & 7; wv[i] = wg[rr * 128 + 8 * q4 + e]; }
#pragma unroll
        for (int i = 0; i < 8; ++i) WQ[lane + 64 * i] = wv[i]; }
    LDS_BARRIER();
    const float qscale = 0.17677669529663687f;
#pragma unroll 1
    for (int rd = 0; rd < rounds; ++rd) {
        { int zz_ = rd; asm volatile("" : "+s"(zz_)); lane = (int)__builtin_amdgcn_mbcnt_hi(~0u, __builtin_amdgcn_mbcnt_lo(~0u, (unsigned)(zz_ - rd))); tid = wave * 64 + lane; r = lane & 15; qd = lane >> 4; }
        const int cidx = dir ? NC - 1 - (4 * rd + n) : 4 * rd + n; const int rowc = row0 + 64 * cidx;
        const int tsgn = dir ? -1 : 1, tbase = dir ? rowc + 63 : rowc;
        size_t zoff = 0; asm volatile("" : "+s"(zoff));
        const bf16* P = (const bf16*)(a.ws + WS_P + zoff);
        float bias[8];
        {   const float* bp = a.in[14] + ((size_t)l * 2 + dir) * 128 + h * 32 + 8 * qd + zoff; const f32x4 b0 = *(const GAS f32x4*)bp, b1 = *(const GAS f32x4*)(bp + 4);
#pragma unroll
            for (int e = 0; e < 4; ++e) { bias[e] = b0[e]; bias[4 + e] = b1[e]; } }
        PMARK(2, false); PMARK(3, true);
        bf16x8 qf[4], kf[4];
        float refv[8], totv[8];
        {
            float la[4][8];
            {
                bf16x8 g0[4], g1[4], vv[8];
#pragma unroll
                for (int mt = 0; mt < 4; ++mt) { const bf16* prow = P + (size_t)(tbase + tsgn * (16 * mt + r)) * LDP + OBc; g0[mt] = *(const GAS bf16x8*)(prow + 768 + dir * 16); g1[mt] = *(const GAS bf16x8*)(prow + 768 + dir * 16 + 8); }
                {   const bf16* vrow = P + (size_t)(tbase + tsgn * lane) * LDP + OBc + 256 + h * 64;
#pragma unroll
                    for (int c8 = 0; c8 < 8; ++c8) vv[c8] = *(const GAS bf16x8*)(vrow + 8 * c8); }
                asm volatile("" : "+v"(g0[0]), "+v"(g0[1]), "+v"(g0[2]), "+v"(g0[3]), "+v"(g1[0]), "+v"(g1[1]), "+v"(g1[2]), "+v"(g1[3]));
                {   float x[4][8];
#pragma unroll
                    for (int mt = 0; mt < 4; ++mt)
#pragma unroll
                        for (int e = 0; e < 8; ++e) x[mt][e] = bias[e];
#pragma unroll
                    for (int rr = 0; rr < 16; ++rr) { const f32x4 w0 = *(const LAS f32x4*)(WQ + (qd * 16 + rr) * 8), w1 = *(const LAS f32x4*)(WQ + (qd * 16 + rr) * 8 + 4);
#pragma unroll
                        for (int mt = 0; mt < 4; ++mt) { const float gkv = bf2f((bf16)(rr < 8 ? g0[mt][rr & 7] : g1[mt][rr & 7]));
#pragma unroll
                            for (int e = 0; e < 4; ++e) { x[mt][e] += gkv * w0[e]; x[mt][4 + e] += gkv * w1[e]; } } }
#pragma unroll
                    for (int mt = 0; mt < 4; ++mt)
#pragma unroll
                        for (int e = 0; e < 8; ++e) la[mt][e] = fast_logsigmoid(x[mt][e]) * (1.0f / 16.0f); }
#pragma unroll
                for (int c8 = 0; c8 < 8; ++c8)
#pragma unroll
                    for (int e = 0; e < 8; ++e) VT[(8 * c8 + e) * 72 + lane] = (bf16)vv[c8][e];
            }
#pragma unroll
            for (int mt = 0; mt < 4; ++mt) { const bf16* prow = P + (size_t)(tbase + tsgn * (16 * mt + r)) * LDP + OBc; qf[mt] = *(const GAS bf16x8*)(prow + h * 32 + 8 * qd); kf[mt] = *(const GAS bf16x8*)(prow + 128 + h * 32 + 8 * qd); }
#pragma unroll
            for (int mt = 0; mt < 4; ++mt)
#pragma unroll
                for (int e = 0; e < 8; ++e) { float v = la[mt][e];
                    v += dpp_f<0x111>(v); v += dpp_f<0x112>(v); v += dpp_f<0x114>(v); v += dpp_f<0x118>(v);
                    la[mt][e] = v; }
#pragma unroll
            for (int e = 0; e < 8; ++e) totv[e] = 0.f;
#pragma unroll
            for (int mt = 0; mt < 4; ++mt) {
#pragma unroll
                for (int e = 0; e < 8; ++e) la[mt][e] += totv[e];
#pragma unroll
                for (int e = 0; e < 8; ++e) totv[e] = bperm_f(lane | 15, la[mt][e]);
                if (mt == 1) {
#pragma unroll
                    for (int e = 0; e < 8; ++e) refv[e] = totv[e]; } }
#pragma unroll
            for (int mt = 0; mt < 4; ++mt) { float qv[8], kv[8];
#pragma unroll
                for (int e = 0; e < 8; ++e) { const float dl = la[mt][e] - refv[e]; qv[e] = bf2f((bf16)qf[mt][e]) * qscale * __expf(dl); kv[e] = bf2f((bf16)kf[mt][e]) * __expf(-dl); }
                qf[mt] = pack8(qv); kf[mt] = pack8(kv);
#pragma unroll
                for (int e = 0; e < 8; ++e) KT[(8 * qd + e) * 72 + 16 * mt + r] = (bf16)kf[mt][e]; }
            if (r == 0) {
#pragma unroll
                for (int e = 0; e < 8; ++e) { VTOT[8 * qd + e] = totv[e]; VSC[8 * qd + e] = totv[e] - refv[e]; } }
        }
        LDS_WAIT(); asm volatile("" ::: "memory");
        PMARK(3, false); PMARK(4, true);
        f32x4 oacc[4][4];
#pragma unroll
        for (int vt = 0; vt < 4; ++vt)
#pragma unroll
            for (int it = 0; it < 4; ++it) oacc[vt][it] = (f32x4){0.f, 0.f, 0.f, 0.f};
#pragma unroll
        for (int s = 0; s < 2; ++s) {
            bf16x8 afr[4];
#pragma unroll
            for (int vt = 0; vt < 4; ++vt) { const unsigned long long lo8 = *(const LAS unsigned long long*)(VT + (16 * vt + r) * 72 + 32 * s + 4 * qd), hi8 = *(const LAS unsigned long long*)(VT + (16 * vt + r) * 72 + 32 * s + 16 + 4 * qd);
                v4u w; w.x = (unsigned)lo8; w.y = (unsigned)(lo8 >> 32); w.z = (unsigned)hi8; w.w = (unsigned)(hi8 >> 32); afr[vt] = __builtin_bit_cast(bf16x8, w); }
#pragma unroll
            for (int it = 0; it < 4; ++it) {
                f32x4 c0 = __builtin_amdgcn_mfma_f32_16x16x32_bf16(kf[2 * s], qf[it], (f32x4){0.f, 0.f, 0.f, 0.f}, 0, 0, 0);
                f32x4 c1 = __builtin_amdgcn_mfma_f32_16x16x32_bf16(kf[2 * s + 1], qf[it], (f32x4){0.f, 0.f, 0.f, 0.f}, 0, 0, 0);
                float pv[8];
#pragma unroll
                for (int e = 0; e < 4; ++e) { const int j0 = 32 * s + 4 * qd + e, j1 = j0 + 16, i = 16 * it + r;
                    const bool k0 = j0 <= i, k1 = j1 <= i;
                    pv[e] = k0 ? c0[e] : 0.f; pv[4 + e] = k1 ? c1[e] : 0.f; }
                const bf16x8 pb = pack8(pv);
#pragma unroll
                for (int vt = 0; vt < 4; ++vt) oacc[vt][it] = __builtin_amdgcn_mfma_f32_16x16x32_bf16(afr[vt], pb, oacc[vt][it], 0, 0, 0);
            }
        }
        {   f32x4 uacc[2][4];
#pragma unroll
            for (int kt = 0; kt < 2; ++kt)
#pragma unroll
                for (int vt = 0; vt < 4; ++vt) uacc[kt][vt] = (f32x4){0.f, 0.f, 0.f, 0.f};
#pragma unroll
            for (int s = 0; s < 2; ++s) { bf16x8 ka[2], vb[4];
#pragma unroll
                for (int kt = 0; kt < 2; ++kt) ka[kt] = *(const LAS bf16x8*)(KT + (16 * kt + r) * 72 + 32 * s + 8 * qd);
#pragma unroll
                for (int vt = 0; vt < 4; ++vt) vb[vt] = *(const LAS bf16x8*)(VT + (16 * vt + r) * 72 + 32 * s + 8 * qd);
#pragma unroll
                for (int kt = 0; kt < 2; ++kt)
#pragma unroll
                    for (int vt = 0; vt < 4; ++vt) uacc[kt][vt] = __builtin_amdgcn_mfma_f32_16x16x32_bf16(ka[kt], vb[vt], uacc[kt][vt], 0, 0, 0); }
            LDS_WAIT(); asm volatile("" ::: "memory");
#pragma unroll
            for (int kt = 0; kt < 2; ++kt) { const f32x4 sc = *(const LAS f32x4*)(VSC + 16 * kt + 4 * qd);
#pragma unroll
                for (int vt = 0; vt < 4; ++vt)
#pragma unroll
                    for (int e = 0; e < 4; ++e) Ureg[(16 * kt + 4 * qd + e) * 64 + 16 * vt + r] = uacc[kt][vt][e] * __expf(sc[e]); }
        }
        PMARK(4, false); PMARK(5, true);
        LDS_BARRIER();
        if (ba < 2) {
            const int item = (ba * 4 + h) * 4 + q, base_item = item - q;
            float* AGG = (float*)(a.ws + WS_AGG + zoff) + (size_t)(l * 32) * 2 * 2112;
            gu32* flags = (gu32*)(a.ws + WS_CTL + zoff) + CW_GLAF + (l * 32) * 64;
            const int d2 = tid >> 8, k = (tid & 255) >> 3, v0 = 8 * (tid & 7);
            {
                f32x4 s0v = (f32x4){0.f, 0.f, 0.f, 0.f}, s1v = (f32x4){0.f, 0.f, 0.f, 0.f}; float lsum = 0.f;
#pragma unroll
                for (int m = 0; m < 4; ++m) { const LAS unsigned char* rm = lds + (2 * m + d2) * 16384; const float tm = ((const LAS float*)(rm + 15872))[k]; const float am = __expf(tm); lsum += tm;
                    s0v = s0v * am + *(const LAS f32x4*)((const LAS float*)rm + k * 64 + v0); s1v = s1v * am + *(const LAS f32x4*)((const LAS float*)rm + k * 64 + v0 + 4); }
                float* dst = AGG + ((size_t)item * 2 + d2) * 2112;
                *(GAS f32x4*)(dst + k * 64 + v0) = s0v; *(GAS f32x4*)(dst + k * 64 + v0 + 4) = s1v;
                if ((tid & 7) == 0) dst[2048 + k] = lsum;
            }
            asm volatile("s_waitcnt vmcnt(0)" ::: "memory");
            __syncthreads();
            if (tid == 0) { __builtin_amdgcn_fence(__ATOMIC_RELEASE, "agent"); asm volatile("s_waitcnt vmcnt(0)" ::: "memory"); __hip_atomic_store(flags + item * 64, 1u, __ATOMIC_RELAXED, __HIP_MEMORY_SCOPE_AGENT); }
            if (wave == 0) {
                for (int qq = 0; qq < 4; ++qq) { if (qq == q) continue; unsigned sp = 0;
                    while (__hip_atomic_load(flags + (base_item + qq) * 64, __ATOMIC_RELAXED, __HIP_MEMORY_SCOPE_AGENT) == 0u) { __builtin_amdgcn_s_sleep(1);
                        if (++sp > (1u << 20)) { if (lane == 0) __hip_atomic_store((gu32*)(a.ws + WS_CTL) + CW_TMO, 1u, __ATOMIC_RELAXED, __HIP_MEMORY_SCOPE_AGENT); break; } } }
                __builtin_amdgcn_fence(__ATOMIC_ACQUIRE, "agent");
                asm volatile("s_waitcnt vmcnt(0)" ::: "memory");
            }
            __syncthreads();
            {
                const float* s0p = a.in[2] + zoff + ((((size_t)ba * DEPTH + l) * 2 + d2) * 4 + h) * 2048 + k * 64 + v0;
                f32x4 s0v = *(const GAS f32x4*)s0p, s1v = *(const GAS f32x4*)(s0p + 4);
#pragma unroll 1
                for (int step = 0; step < 3; ++step) { const int qq = d2 ? 3 - step : step; const bool use = d2 ? (qq > q) : (qq < q);
                    if (use) { const float* srcp = AGG + ((size_t)(base_item + qq) * 2 + d2) * 2112; const float am = __expf(*(const GAS float*)(srcp + 2048 + k));
                        s0v = s0v * am + *(const GAS f32x4*)(srcp + k * 64 + v0); s1v = s1v * am + *(const GAS f32x4*)(srcp + k * 64 + v0 + 4); } }
                *(LAS f32x4*)(SRUN + d2 * 2048 + k * 64 + v0) = s0v; *(LAS f32x4*)(SRUN + d2 * 2048 + k * 64 + v0 + 4) = s1v;
            }
            __syncthreads();
        }
        {   float ex[8];
#pragma unroll
            for (int e = 0; e < 8; ++e) ex[e] = __expf(refv[e]);
#pragma unroll
            for (int vt = 0; vt < 4; ++vt) { float sv[8];
#pragma unroll
                for (int e = 0; e < 8; ++e) sv[e] = SRUN[dir * 2048 + (8 * qd + e) * 64 + 16 * vt + r];
                for (int m = 0; m < n; ++m) { const LAS unsigned char* rm = lds + (2 * m + dir) * 16384; const LAS float* Um = (const LAS float*)rm; const LAS float* Tm = (const LAS float*)(rm + 15872);
#pragma unroll
                    for (int e = 0; e < 8; ++e) sv[e] = __expf(Tm[8 * qd + e]) * sv[e] + Um[(8 * qd + e) * 64 + 16 * vt + r]; }
#pragma unroll
                for (int e = 0; e < 8; ++e) sv[e] *= ex[e];
                const bf16x8 sa = pack8(sv);
#pragma unroll
                for (int it = 0; it < 4; ++it) oacc[vt][it] = __builtin_amdgcn_mfma_f32_16x16x32_bf16(sa, qf[it], oacc[vt][it], 0, 0, 0); }
        }
        PMARK(5, false); PMARK(6, true);
        unsigned long long gm[2][4];
#pragma unroll
        for (int it = 0; it < 2; ++it)
#pragma unroll
            for (int vt = 0; vt < 4; ++vt) gm[it][vt] = *(const GAS unsigned long long*)(P + (size_t)(tbase + tsgn * (16 * it + r)) * LDP + OBc + 512 + h * 64 + 16 * vt + 4 * qd);
        LDS_BARRIER();
        if (ba >= 2) {   const int k = 8 * n + (lane >> 3), v0 = 8 * (lane & 7);
            f32x4 s0 = *(const LAS f32x4*)(SRUN + dir * 2048 + k * 64 + v0), s1 = *(const LAS f32x4*)(SRUN + dir * 2048 + k * 64 + v0 + 4);
#pragma unroll
            for (int m = 0; m < 4; ++m) { const LAS unsigned char* rm = lds + (2 * m + dir) * 16384; const float am = __expf(((const LAS float*)(rm + 15872))[k]);
                s0 = s0 * am + *(const LAS f32x4*)((const LAS float*)rm + k * 64 + v0); s1 = s1 * am + *(const LAS f32x4*)((const LAS float*)rm + k * 64 + v0 + 4); }
            float* so = a.out + zoff + (size_t)M * D + ((((size_t)(ba - 2) * DEPTH + l) * 2 + dir) * 4 + h) * 2048 + k * 64 + v0;
            *(GAS f32x4*)so = s0; *(GAS f32x4*)(so + 4) = s1;
        }
        LDS_BARRIER();
        LAS float* OL = (LAS float*)reg;
#pragma unroll
        for (int it = 2; it < 4; ++it)
#pragma unroll
            for (int vt = 0; vt < 4; ++vt) *(LAS f32x4*)(OL + ((it - 2) * 16 + r) * 64 + (((4 * vt + qd) ^ r) & 15) * 4) = oacc[vt][it];
        LDS_BARRIER();
        {
            const LAS float* OP = (const LAS float*)(lds + (2 * (3 - n) + (dir ^ 1)) * 16384);
            bf16* MIX = (bf16*)(a.ws + WS_MIX + zoff);
            f32x4 gnv[4];
#pragma unroll
            for (int vt = 0; vt < 4; ++vt) gnv[vt] = *(const GAS f32x4*)(a.in[15] + zoff + (size_t)l * 64 + 16 * vt + 4 * qd);
#pragma unroll
            for (int it = 0; it < 2; ++it) { float ss = 0.f; const int pr = 15 - r, pt = (1 - it) * 16 + pr;
#pragma unroll
                for (int vt = 0; vt < 4; ++vt) { const f32x4 o = oacc[vt][it] + *(const LAS f32x4*)(OP + pt * 64 + (((4 * vt + qd) ^ pr) & 15) * 4); oacc[vt][it] = o; ss += (o[0] * o[0] + o[1] * o[1]) + (o[2] * o[2] + o[3] * o[3]); }
                ss += bperm_f(lane ^ 16, ss); ss += bperm_f(lane ^ 32, ss);
                const float rn = __builtin_amdgcn_rsqf(ss * (1.0f / 64.0f) + EPS);
#pragma unroll
                for (int vt = 0; vt < 4; ++vt) { float y[4];
#pragma unroll
                    for (int e2 = 0; e2 < 4; ++e2) y[e2] = oacc[vt][it][e2] * rn * gnv[vt][e2] * silu_fast(bf2f((bf16)(gm[it][vt] >> (16 * e2))));
                    *(GAS unsigned long long*)(MIX + (size_t)(tbase + tsgn * (16 * it + r)) * D + 256 + h * 64 + 16 * vt + 4 * qd) = (unsigned long long)pk2(y[0], y[1]) | ((unsigned long long)pk2(y[2], y[3]) << 32); } }
        }
    }
    LDS_BARRIER();
    PMARK(6, false); PMARK(1, false);
}

__device__ __forceinline__ void mlp_mfma_item(const Args& a, int l, int chunk, LAS unsigned char* lds, int tid, int wave) {
    const int r0 = chunk * 128, lane = tid & 63, r = lane & 15, qd = lane >> 4;
    const bf16* P = (const bf16*)(a.ws + WS_P); bf16* MIX = (bf16*)(a.ws + WS_MIX);
    LAS bf16* VVT = (LAS bf16*)lds;
    PMARK(20, true); PMARK(21, true);
    {   const int j = tid >> 2, part = tid & 3;
        const bf16* prow = P + (size_t)(r0 + j) * LDP + OCc + 256 + part * 64;
        float v[64]; float s = 0.f;
#pragma unroll
        for (int e8 = 0; e8 < 8; ++e8) { const bf16x8 raw = *(const GAS bf16x8*)(prow + 8 * e8);
#pragma unroll
            for (int e = 0; e < 8; ++e) { const float x = gelu_fast(bf2f((bf16)raw[e])); v[8 * e8 + e] = x; s += x; } }
        s += dpp_f<0xB1>(s); s += dpp_f<0x4E>(s);
        const float mu = s * (1.0f / 256.0f); float q = 0.f;
#pragma unroll
        for (int e = 0; e < 64; ++e) { const float d = v[e] - mu; q += d * d; }
        q += dpp_f<0xB1>(q); q += dpp_f<0x4E>(q);
        const float rstd = 1.0f / sqrtf(q * (1.0f / 256.0f) + EPS);
        const float* lg = a.in[16] + (size_t)l * 256 + part * 64;
#pragma unroll
        for (int e = 0; e < 64; ++e) VVT[(part * 64 + e) * 136 + j] = (bf16)f2bf((v[e] - mu) * rstd * lg[e]);
    }
    LDS_BARRIER();
    PMARK(21, false); PMARK(22, true);
    {   const int g = wave >> 1, ih = wave & 1;
        const float* wsg = a.in[17] + ((size_t)l * 4 + g) * 128 * 128;
        f32x4 acc[4][4];
#pragma unroll
        for (int ct = 0; ct < 4; ++ct)
#pragma unroll
            for (int it = 0; it < 4; ++it) acc[ct][it] = (f32x4){0.f, 0.f, 0.f, 0.f};
#pragma unroll 1
        for (int sp = 0; sp < 2; ++sp) {
            bf16x8 bfr[4][2];
            {   f32x4 w0[4][2], w1[4][2];
#pragma unroll
                for (int it = 0; it < 4; ++it)
#pragma unroll
                    for (int s2 = 0; s2 < 2; ++s2) { const float* wr = wsg + (size_t)(64 * ih + 16 * it + r) * 128 + 32 * (2 * sp + s2) + 8 * qd; w0[it][s2] = *(const GAS f32x4*)wr; w1[it][s2] = *(const GAS f32x4*)(wr + 4); }
#pragma unroll
                for (int it = 0; it < 4; ++it)
#pragma unroll
                    for (int s2 = 0; s2 < 2; ++s2) { v4u w; w.x = pk2(w0[it][s2][0], w0[it][s2][1]); w.y = pk2(w0[it][s2][2], w0[it][s2][3]); w.z = pk2(w1[it][s2][0], w1[it][s2][1]); w.w = pk2(w1[it][s2][2], w1[it][s2][3]); bfr[it][s2] = __builtin_bit_cast(bf16x8, w); } }
#pragma unroll
            for (int s2 = 0; s2 < 2; ++s2) { bf16x8 af[4];
#pragma unroll
                for (int ct = 0; ct < 4; ++ct) af[ct] = *(const LAS bf16x8*)(VVT + (64 * g + 16 * ct + r) * 136 + 32 * (2 * sp + s2) + 8 * qd);
#pragma unroll
                for (int it = 0; it < 4; ++it)
#pragma unroll
                    for (int ct = 0; ct < 4; ++ct) acc[ct][it] = __builtin_amdgcn_mfma_f32_16x16x32_bf16(af[ct], bfr[it][s2], acc[ct][it], 0, 0, 0); } }
        unsigned long long um[4][4];
#pragma unroll
        for (int it = 0; it < 4; ++it)
#pragma unroll
            for (int ct = 0; ct < 4; ++ct) um[it][ct] = *(const GAS unsigned long long*)(P + (size_t)(r0 + 64 * ih + 16 * it + r) * LDP + OCc + 64 * g + 16 * ct + 4 * qd);
        asm volatile("" : "+v"(um[0][0]), "+v"(um[1][0]), "+v"(um[2][0]), "+v"(um[3][3]));
        PMARK(22, false); PMARK(23, true);
        const float* bs = a.in[18] + ((size_t)l * 4 + g) * 128;
#pragma unroll
        for (int it = 0; it < 4; ++it) { const int i = 64 * ih + 16 * it + r; const float bsi = bs[i]; const size_t row = (size_t)(r0 + i);
#pragma unroll
            for (int ct = 0; ct < 4; ++ct) { const int c = 64 * g + 16 * ct + 4 * qd;
                float y[4];
#pragma unroll
                for (int e = 0; e < 4; ++e) y[e] = gelu_fast(bf2f((bf16)(um[it][ct] >> (16 * e)))) * (acc[ct][it][e] + bsi);
                *(GAS unsigned long long*)(MIX + row * D + 512 + c) = (unsigned long long)pk2(y[0], y[1]) | ((unsigned long long)pk2(y[2], y[3]) << 32); } }
    }
    LDS_BARRIER();
    PMARK(23, false); PMARK(20, false);
}

__device__ __forceinline__ void aconv_item(const Args& a, int l, int item, int tid) {
    const bf16* P = (const bf16*)(a.ws + WS_P); bf16* MIX = (bf16*)(a.ws + WS_MIX);
    const float* ca = a.in[12] + (size_t)l * 768;
    const int c8 = 8 * (tid & 31);
    float w[3][8];
#pragma unroll
    for (int d = 0; d < 3; ++d)
#pragma unroll
        for (int e = 0; e < 8; ++e) w[d][e] = ca[d * 256 + c8 + e];
#pragma unroll
    for (int i = 0; i < 4; ++i) { const int row = item * 64 + (tid >> 5) + 16 * i;
        const int wpos = (row < NCTX) ? (row & 255) : ((row - NCTX) & 63); const int row_w = (row < NCTX) ? LC : GRIDW;
        const bf16* p = P + (size_t)row * LDP;
        float s[8];
#pragma unroll
        for (int e = 0; e < 8; ++e) s[e] = 0.f;
#pragma unroll
        for (int d = -1; d <= 1; ++d) { if (wpos + d >= 0 && wpos + d < row_w) { const bf16x8 cg = *(const GAS bf16x8*)(p + d * LDP + 256 + c8), xa = *(const GAS bf16x8*)(p + d * LDP + 512 + c8);
#pragma unroll
                for (int e = 0; e < 8; ++e) s[e] += w[d + 1][e] * bf2f((bf16)cg[e]) * bf2f((bf16)xa[e]); } }
        const bf16x8 bg = *(const GAS bf16x8*)(p + c8); float y[8];
#pragma unroll
        for (int e = 0; e < 8; ++e) y[e] = bf2f((bf16)bg[e]) * s[e];
        *(GAS bf16x8*)(MIX + (size_t)row * D + c8) = pack8(y); }
}

#define LAUNDER_TID() int zz_ = 0; asm volatile("" : "+s"(zz_)); const int lane = (int)__builtin_amdgcn_mbcnt_hi(~0u, __builtin_amdgcn_mbcnt_lo(~0u, (unsigned)zz_)); const int tid = wave * 64 + lane; (void)lane
template <int PARTS = 31>
__device__ __forceinline__ void mix_heavy_phase(const Args& a, int l, LAS unsigned char* lds, int G, int wave, int tid_in) {
    const int bx = blockIdx.x;
    if (bx < 32) { if (PARTS & 1) { LAUNDER_TID(); gla_mfma_item(a, l, bx >> 4, (bx >> 2) & 3, bx & 3, lds, tid, wave); }
        if (PARTS & 8) for (int it = bx; it < 96; it += 32) { LAUNDER_TID(); aconv_item(a, l, it, tid); }
        return; }
    const int W = G - 32, w0 = bx - 32;
    if (PARTS & 16) for (int it = w0; it < 128; it += W) { LAUNDER_TID(); gla_mfma_item(a, l, 2 + (it >> 2), it & 3, 0, lds, tid, wave); }
    if (PARTS & 2) for (int it = ((w0 - 128) % W + W) % W; it < 64; it += W) { LAUNDER_TID(); hyena_mfma_item<1>(a, l, it, lds, tid, wave); }
    if (PARTS & 4) for (int it = ((w0 - 192) % W + W) % W; it < 128; it += W) { LAUNDER_TID(); hyena_mfma_item<0>(a, l, it, lds, tid, wave); }
    if (PARTS & 8) for (int it = ((w0 - 320) % W + W) % W; it < 80; it += W) { LAUNDER_TID(); mlp_mfma_item(a, l, it, lds, tid, wave); }
    if (PARTS & 8) { const int ai = (w0 >= 176) ? 96 + (w0 - 176) : ((w0 >= 96 && w0 < 112) ? 144 + (w0 - 96) : -1);
        if (ai >= 0) { LAUNDER_TID(); aconv_item(a, l, ai, tid); } }
}

__global__ void __launch_bounds__(NTHREADS, 2) fwd_kernel(Args args) {
    extern __shared__ __attribute__((aligned(16))) unsigned char lds_raw[];
    LAS unsigned char* lds = (LAS unsigned char*)lds_raw;
    volatile LAS unsigned* MISC = (volatile LAS unsigned*)(lds + MISC_OFF);
    const int tid = threadIdx.x, lane = tid & 63, wave = __builtin_amdgcn_readfirstlane(tid >> 6);
    const int G = gridDim.x; const int bx = blockIdx.x; const int vcu = (G % 8 == 0) ? (bx % 8) * (G / 8) + bx / 8 : bx;
    gu32* ctl = (gu32*)(args.ws + WS_CTL);
    for (int u = tid; u < (LDS_BYTES - LDSCTL_OFF) / 4; u += NTHREADS) ((LAS unsigned*)(lds + LDSCTL_OFF))[u] = 0u;
    __syncthreads();
    XcdBarrier bar; bar.bar = (unsigned*)(ctl + CW_BAR); bar.x = 0; bar.st = nullptr;
    if (!MK_PER_PHASE) bar = xcd_barrier_post((unsigned*)(ctl + CW_BAR), MISC + 8);
    const int lo = args.ph_lo, hi = args.ph_hi;
#define PH_BEGIN(k) if (lo <= (k) && (k) < hi) { int zero_o = 0; asm volatile("" : "+s"(zero_o)); \
        const int lane_o = (int)__builtin_amdgcn_mbcnt_hi(~0u, __builtin_amdgcn_mbcnt_lo(~0u, (unsigned)zero_o)); const int tid_o = wave * 64 + lane_o; (void)tid_o; probe_mark(args.ws, 100 + (k), true, wave, 0);
#define PH_END(k) if ((k) + 1 < hi) { XcdBarrier barp = bar; asm volatile("" : "+s"(barp.bar)); xcd_barrier(barp, tid_o); } probe_mark(args.ws, 100 + (k), false, wave, 0); }
#define DUP_BEGIN() { int zero_o = 0; asm volatile("" : "+s"(zero_o)); \
        const int lane_o = (int)__builtin_amdgcn_mbcnt_hi(~0u, __builtin_amdgcn_mbcnt_lo(~0u, (unsigned)zero_o)); const int tid_o = wave * 64 + lane_o; (void)tid_o;
#define DUP_END() { XcdBarrier barp = bar; asm volatile("" : "+s"(barp.bar)); xcd_barrier(barp, tid_o); } }
    PH_BEGIN(0) p0_prologue(args, lds, vcu, G, wave, lane_o, tid_o); PH_END(0)
#if PROBE_KIND == 100
    DUP_BEGIN() p0_prologue(args, lds, vcu, G, wave, lane_o, tid_o); DUP_END()
#endif
#if PROBE_KIND == 101
    DUP_BEGIN() p1_table_phase(args, vcu, G, wave, lane_o); row_phase(args, 0, 0, vcu, G, wave, lane_o); DUP_END()
#endif
#if PROBE_KIND == 102
    DUP_BEGIN() mix_heavy_phase(args, 0, lds, G, wave, tid_o); DUP_END()
#endif
#if PROBE_KIND == 103
    DUP_BEGIN() { unsigned char* wl = args.ws + WS_W; pg8::Gemm g{(const pg8::bf16_t*)(args.ws + WS_H), (const pg8::bf16_t*)(wl + W_13), M, 2 * FF, D}; pg8::StaticOrder S; S.init(M, 2 * FF, G, bx);
        pg8::EpiSwiGLU E{(pg8::bf16_t*)(args.ws + WS_P), FF};
        pg8::gemm_phase<pg8::EpiSwiGLU, pg8::StaticOrder, true, true>(lds + RING_OFF, g, S, E, tid_o); } DUP_END()
#endif
#if PROBE_KIND == 104
    DUP_BEGIN() { unsigned char* wl = args.ws + WS_W; pg8::Gemm g{(const pg8::bf16_t*)(args.ws + WS_P), (const pg8::bf16_t*)(wl + W_2), M, D, FF}; pg8::StaticOrder S; S.init(M, D, G, bx);
        pg8::EpiF32 E{(float*)(args.ws + WS_MF), D};
        pg8::gemm_phase<pg8::EpiF32, pg8::StaticOrder, true, true>(lds + RING_OFF, g, S, E, tid_o); } DUP_END()
#endif
#if PROBE_KIND == 105
    DUP_BEGIN() row_phase(args, 0, 0, vcu, G, wave, lane_o); DUP_END()
#endif
#if PROBE_KIND == 106
    DUP_BEGIN() DUP_END()
    DUP_BEGIN() DUP_END()
    DUP_BEGIN() DUP_END()
    DUP_BEGIN() DUP_END()
#endif
#if PROBE_KIND >= 200 && PROBE_KIND < 232
#define HEAVY_DUP(l) DUP_BEGIN() mix_heavy_phase<PROBE_KIND - 200>(args, l, lds, G, wave, tid_o); DUP_END()
#else
#define HEAVY_DUP(l)
#endif
#if PROBE_KIND == 301
#define G1_DUP(l) DUP_BEGIN() { unsigned char* wl = args.ws + WS_W + (size_t)(l) * W_LAYER; pg8::Gemm g{(const pg8::bf16_t*)(args.ws + WS_H), (const pg8::bf16_t*)(wl + W_IN), M, INP, D}; pg8::StaticOrder S; S.init(M, INP, G, bx); \
        pg8::EpiP E{(pg8::bf16_t*)(args.ws + WS_P), (pg8::bf16_t*)(args.ws + WS_PHY), LDP, M}; pg8::gemm_phase<pg8::EpiP, pg8::StaticOrder, true, true>(lds + RING_OFF, g, S, E, tid_o); } DUP_END()
#else
#define G1_DUP(l)
#endif
#if PROBE_KIND == 3020
#define G3_DUP(l) DUP_BEGIN() { unsigned char* wl = args.ws + WS_W + (size_t)(l) * W_LAYER; pg8::Gemm g{(const pg8::bf16_t*)(args.ws + WS_H), (const pg8::bf16_t*)(wl + W_OUT), M, D, D}; pg8::StaticOrder S; S.init(M, D, G, bx); \
        pg8::EpiF32 E{(float*)(args.ws + WS_MF), D}; pg8::gemm_phase<pg8::EpiF32, pg8::StaticOrder, true, true>(lds + RING_OFF, g, S, E, tid_o); } DUP_END()
#elif PROBE_KIND == 3040
#define G3_DUP(l) DUP_BEGIN() { unsigned char* wl = args.ws + WS_W + (size_t)(l) * W_LAYER; pg8::Gemm g{(const pg8::bf16_t*)(args.ws + WS_P), (const pg8::bf16_t*)(wl + W_2), M, D, FF}; pg8::StaticOrder S; S.init(M, D, G, bx); \
        pg8::EpiF32 E{(float*)(args.ws + WS_MF), D}; pg8::gemm_phase<pg8::EpiF32, pg8::StaticOrder, true, true>(lds + RING_OFF, g, S, E, tid_o); } DUP_END()
#elif PROBE_KIND == 303
#define G3_DUP(l) DUP_BEGIN() { unsigned char* wl = args.ws + WS_W + (size_t)(l) * W_LAYER; pg8::Gemm g{(const pg8::bf16_t*)(args.ws + WS_H), (const pg8::bf16_t*)(wl + W_13), M, 2 * FF, D}; pg8::StaticOrder S; S.init(M, 2 * FF, G, bx); \
        pg8::EpiSwiGLU E{(pg8::bf16_t*)(args.ws + WS_P), FF}; pg8::gemm_phase<pg8::EpiSwiGLU, pg8::StaticOrder, true, true>(lds + RING_OFF, g, S, E, tid_o); } DUP_END()
#else
#define G3_DUP(l)
#endif
#if PROBE_KIND == 305
#define ROW_DUP(l) if ((l) == 0) { DUP_BEGIN() row_phase(args, 0, 1, vcu, G, wave, lane_o); DUP_END() DUP_BEGIN() row_phase(args, 0, 1, vcu, G, wave, lane_o); DUP_END() }
#else
#define ROW_DUP(l)
#endif
#define LAYER(l, B) \
    PH_BEGIN(B + 0) { unsigned char* wl = args.ws + WS_W + (size_t)(l) * W_LAYER; \
        pg8::Gemm g{(const pg8::bf16_t*)(args.ws + WS_H), (const pg8::bf16_t*)(wl + W_IN), M, INP, D}; pg8::StaticOrder S; S.init(M, INP, G, bx); \
        pg8::EpiP E{(pg8::bf16_t*)(args.ws + WS_P), (pg8::bf16_t*)(args.ws + WS_PHY), LDP, M}; \
        pg8::gemm_phase<pg8::EpiP, pg8::StaticOrder, true, true>(lds + RING_OFF, g, S, E, tid_o); \
        if ((l) == 0 && bx >= 224 && bx < 240) { int zz_ = 0; asm volatile("" : "+s"(zz_)); const int lane2 = (int)__builtin_amdgcn_mbcnt_hi(~0u, __builtin_amdgcn_mbcnt_lo(~0u, (unsigned)zz_)); \
            __syncthreads(); late_filter_item(args, 144 + (bx - 224), lds, wave, lane2, wave * 64 + lane2); } } PH_END(B + 0) \
    G1_DUP(l) \
    PH_BEGIN(B + 1) mix_heavy_phase(args, l, lds, G, wave, tid_o); \
PH_END(B + 1) \
    HEAVY_DUP(l) \
    PH_BEGIN(B + 2) { unsigned char* wl = args.ws + WS_W + (size_t)(l) * W_LAYER; \
        pg8::Gemm g{(const pg8::bf16_t*)(args.ws + WS_MIX), (const pg8::bf16_t*)(wl + W_OUT), M, D, D}; pg8::StaticOrder S; S.init(M, D, G, bx); \
        pg8::EpiBf16<0> E{(pg8::bf16_t*)(args.ws + WS_MF), D, nullptr, 0, 0, 1.f}; \
        pg8::gemm_phase<pg8::EpiBf16<0>, pg8::StaticOrder, true, true>(lds + RING_OFF, g, S, E, tid_o); \
        if ((l) == 0 && bx >= 160) { int zz_ = 0; asm volatile("" : "+s"(zz_)); const int lane2 = (int)__builtin_amdgcn_mbcnt_hi(~0u, __builtin_amdgcn_mbcnt_lo(~0u, (unsigned)zz_)); \
            convert_items(args, 0, C_OUT, C_13, (bx - 160) * NWAVES + wave, (G - 160) * NWAVES, (LAS float*)(lds + RING_OFF + wave * 16384), lane2); } } PH_END(B + 2) \
    PH_BEGIN(B + 3) row_phase(args, l, 1, vcu, G, wave, lane_o); PH_END(B + 3) \
    ROW_DUP(l) \
    PH_BEGIN(B + 4) { unsigned char* wl = args.ws + WS_W + (size_t)(l) * W_LAYER; \
        pg8::Gemm g{(const pg8::bf16_t*)(args.ws + WS_H), (const pg8::bf16_t*)(wl + W_13), M, 2 * FF, D}; pg8::StaticOrder S; S.init(M, 2 * FF, G, bx); \
        pg8::EpiSwiGLU E{(pg8::bf16_t*)(args.ws + WS_P), FF}; \
        pg8::gemm_phase<pg8::EpiSwiGLU, pg8::StaticOrder, true, true>(lds + RING_OFF, g, S, E, tid_o); \
        if ((l) == 0 && bx >= 112) { int zz_ = 0; asm volatile("" : "+s"(zz_)); const int lane2 = (int)__builtin_amdgcn_mbcnt_hi(~0u, __builtin_amdgcn_mbcnt_lo(~0u, (unsigned)zz_)); \
            convert_items(args, 0, C_13, C_2, (bx - 112) * NWAVES + wave, (G - 112) * NWAVES, (LAS float*)(lds + RING_OFF + wave * 16384), lane2); \
            __syncthreads(); late_filter_item(args, bx - 112, lds, wave, lane2, wave * 64 + lane2); } } PH_END(B + 4) \
    G3_DUP(l) \
    PH_BEGIN(B + 5) { unsigned char* wl = args.ws + WS_W + (size_t)(l) * W_LAYER; \
        pg8::Gemm g{(const pg8::bf16_t*)(args.ws + WS_P), (const pg8::bf16_t*)(wl + W_2), M, D, FF}; pg8::StaticOrder S; S.init(M, D, G, bx); \
        pg8::EpiBf16<0> E{(pg8::bf16_t*)(args.ws + WS_MF), D, nullptr, 0, 0, 1.f}; \
        pg8::gemm_phase<pg8::EpiBf16<0>, pg8::StaticOrder, true, true>(lds + RING_OFF, g, S, E, tid_o); \
        if ((l) == 0 && bx >= 160) { int zz_ = 0; asm volatile("" : "+s"(zz_)); const int lane2 = (int)__builtin_amdgcn_mbcnt_hi(~0u, __builtin_amdgcn_mbcnt_lo(~0u, (unsigned)zz_)); \
            late_mod_item(args, bx - 160, lds, wave, lane2, wave * 64 + lane2); \
            convert_items(args, 1, 0, C_2, (bx - 160) * NWAVES + wave, (G - 160) * NWAVES, (LAS float*)(lds + RING_OFF + wave * 16384), lane2); } } PH_END(B + 5) \
    PH_BEGIN(B + 6) row_phase(args, l, 2, vcu, G, wave, lane_o); PH_END(B + 6)
    LAYER(0, 1)
    LAYER(1, 8)
#undef LAYER
#undef PH_BEGIN
#undef PH_END
    probe_stretch(args.ws, wave);
}

extern "C" void kernel_launch(void* const* d_in, const int* in_sizes, int n_in, void* d_out, int out_size, void* d_ws, size_t ws_size, hipStream_t stream) {
    static int grid = 0;
    if (grid == 0) {
        if (n_in != 32 || ws_size < WS_END) { fprintf(stderr, "kernel_launch: unexpected inputs (n_in %d, ws %zu)\n", n_in, ws_size); grid = -1; return; }
        int dev = 0, cus = 0, per_cu = 0;
        if (hipGetDevice(&dev) != hipSuccess || hipDeviceGetAttribute(&cus, hipDeviceAttributeMultiprocessorCount, dev) != hipSuccess) { grid = -1; return; }
        if (hipFuncSetAttribute((const void*)fwd_kernel, hipFuncAttributeMaxDynamicSharedMemorySize, LDS_BYTES) != hipSuccess) { fprintf(stderr, "kernel_launch: hipFuncSetAttribute failed\n"); grid = -1; return; }
        if (hipOccupancyMaxActiveBlocksPerMultiprocessor(&per_cu, (const void*)fwd_kernel, NTHREADS, LDS_BYTES) != hipSuccess || per_cu < 1) { fprintf(stderr, "kernel_launch: occupancy query says %d blocks per CU\n", per_cu); }
        (void)hipGetLastError();
        grid = cus;
    }
    if (grid < 0) return;
    (void)hipMemsetAsync((char*)d_ws + WS_CTL, 0, CTL_ZERO_BYTES, stream);
    Args a{};
    for (int i = 0; i < 32; ++i) a.in[i] = (const float*)d_in[i];
    a.out = (float*)d_out; a.ws = (unsigned char*)d_ws;
#if MK_PER_PHASE
    for (int p = 0; p < NPHASE; ++p) { a.ph_lo = p; a.ph_hi = p + 1; a.li = p; hipLaunchKernelGGL(fwd_kernel, dim3(grid), dim3(NTHREADS), LDS_BYTES, stream, a); }
#else
    a.ph_lo = 0; a.ph_hi = NPHASE; a.li = 0;
    hipLaunchKernelGGL(fwd_kernel, dim3(grid), dim3(NTHREADS), LDS_BYTES, stream, a);
#endif
}
```

```cpp
#include <hip/hip_runtime.h>
#include <cstdio>
#include <cstdint>
namespace pg8 {
#define PG8_LAS __attribute__((address_space(3)))
typedef unsigned short bf16_t;
typedef short bf16x8 __attribute__((ext_vector_type(8)));
typedef float f32x4 __attribute__((ext_vector_type(4)));
typedef unsigned u32x4 __attribute__((ext_vector_type(4)));
constexpr int BM = 256, BK = 64, HALF = 128, HTB = HALF * BK * 2  , STAGE_BYTES = 8 * HTB, NXCD = 8, WGM = 5;

__host__ __device__ __forceinline__ int lds_byte(int r, int c) { const int st = (r >> 4) * 2 + (c >> 5), rr = r & 15, cc = c & 31, ob = rr * 64 + cc * 2; return st * 1024 + (ob ^ (((ob >> 9) & 1) << 5)); }
__host__ __device__ __forceinline__ void stage_rc(int b, int& R, int& C) { const int st = b / 1024, sb = b % 1024, swz = sb ^ (((sb >> 9) & 1) << 5); R = (st >> 1) * 16 + swz / 64; C = (st & 1) * 32 + (swz % 64) / 2; }
__host__ __device__ __forceinline__ int perm32(int rho) { const int n = rho >> 4, i = rho & 15; return 8 * (i >> 2) + 4 * n + (i & 3); }

struct Unit { int pm, pn, k0, nt, part; };
struct Gemm { const bf16_t* A; const bf16_t* Bt; int M, N, K; };

struct StaticOrder {
    int nM, nN, nwg, G, c;
    __host__ __device__ void init(int M, int N, int G_, int c_) { nM = M / BM; nN = N / BM; nwg = nM * nN; G = G_; c = c_; }
    static constexpr bool SPLITK = false;
    __host__ __device__ void tile(int wgid, Unit& u) const {
        { const int q = nwg / NXCD, r = nwg % NXCD, xcd = wgid % NXCD, off = wgid / NXCD; wgid = (xcd < r ? xcd * (q + 1) : r * (q + 1) + (xcd - r) * q) + off; }
        const int nig = WGM * nN, gid = wgid / nig, fm = gid * WGM, gsz = (nM - fm) < WGM ? (nM - fm) : WGM;
        u.pm = fm + ((wgid % nig) % gsz); u.pn = (wgid % nig) / gsz;
    }
    __host__ __device__ bool next(int i, Unit& u) const {
        const long L = (long)i * G + c; if (L >= nwg) return false;
        tile((int)L, u); return true;
    }
    __device__ __forceinline__ void a_ready(const Unit&) const {}
    __device__ __forceinline__ void done(const Unit&) const {}
};
struct SplitOrder {
    static constexpr bool SPLITK = true;
    StaticOrder base; int c, nidle, ktm, ktot;
    __host__ __device__ void init(int M, int N, int G_, int c_, int ktm_, int ktot_) { base.init(M, N, G_, 0); c = c_; nidle = G_ - base.nwg; ktm = ktm_; ktot = ktot_; }
    __host__ __device__ bool next(int i, Unit& u) const {
        if (c < base.nwg) { if (i) return false; base.tile(c, u); u.k0 = 0; u.nt = ktm; u.part = 0; return true; }
        const int p = (c - base.nwg) + nidle * i; if (p >= base.nwg) return false;
        base.tile(p, u); u.k0 = ktm; u.nt = ktot - ktm; u.part = 1; return true;
    }
    __device__ __forceinline__ void a_ready(const Unit&) const {}
    __device__ __forceinline__ void done(const Unit&) const {}
};

__device__ __forceinline__ unsigned cvt_pk_bf16(float lo, float hi) { unsigned r; asm volatile("v_cvt_pk_bf16_f32 %0, %1, %2" : "=v"(r) : "v"(lo), "v"(hi)); return r; }
typedef float f32x2 __attribute__((ext_vector_type(2)));
__device__ __forceinline__ f32x2 gelu_pk(f32x2 v) {
    const f32x2 av = __builtin_elementwise_abs(v), d = av * 0.2316418882f + 1.0f;
    f32x2 t; t.x = __builtin_amdgcn_rcpf(d.x); t.y = __builtin_amdgcn_rcpf(d.y);
    f32x2 q = t * 0.5307027145f + (-0.7265760135f); q = q * t + 0.7107068705f; q = q * t + (-0.142248368f); q = q * t + 0.127414796f; q = q * t;
    const f32x2 s = (v * v) * (-0.72134752044f);
    f32x2 e; e.x = __builtin_amdgcn_exp2f(s.x); e.y = __builtin_amdgcn_exp2f(s.y);
    const f32x2 m = v * (q * e), r = v - m;
    f32x2 o; o.x = v.x < 0.f ? m.x : r.x; o.y = v.y < 0.f ? m.y : r.y; return o;
}

template <int ACT  > struct EpiBf16 {
    static constexpr bool PERM = true, AFTER_DRAIN = false; static_assert(ACT == 0 || ACT == 1, "EpiBf16: ACT is 0 (none) or 1 (gelu_pk)");
    bf16_t* O; int ldc; const float* bias; int split_cols; size_t split_stride; float scale0;
    __device__ __forceinline__ void operator()(const f32x4 (&acc)[2][2][4][2], const Unit& u, int wr, int wc, int fr, int fq) const {
        const int row0 = u.pm * BM + wr * 64 + fr; int colt = u.pn * BM; bf16_t* base = O;
        float sc = 1.f; if (split_cols) { const int t = colt / split_cols; base += (size_t)t * split_stride; colt -= t * split_cols; if (t == 0) sc = scale0; }
        const int col0 = colt + wc * 32 + 8 * fq, bcol0 = u.pn * BM + wc * 32 + 8 * fq;
        f32x4 bv[2][2];
#pragma unroll
        for (int bj = 0; bj < 2; ++bj)
#pragma unroll
            for (int n = 0; n < 2; ++n) bv[bj][n] = bias ? *(const f32x4*)(bias + bcol0 + bj * HALF + 4 * n) : (f32x4){0.f, 0.f, 0.f, 0.f};
#pragma unroll
        for (int ai = 0; ai < 2; ++ai)
#pragma unroll
            for (int m = 0; m < 4; ++m) { bf16_t* rowp = base + (size_t)(row0 + ai * HALF + m * 16) * ldc + col0;
#pragma unroll
                for (int bj = 0; bj < 2; ++bj) { f32x4 v0 = acc[ai][bj][m][0] + bv[bj][0], v1 = acc[ai][bj][m][1] + bv[bj][1];
                    if (ACT == 1) { f32x2 a = gelu_pk((f32x2){v0[0], v0[1]}), b = gelu_pk((f32x2){v0[2], v0[3]}), c = gelu_pk((f32x2){v1[0], v1[1]}), d = gelu_pk((f32x2){v1[2], v1[3]});
                        v0 = (f32x4){a.x, a.y, b.x, b.y}; v1 = (f32x4){c.x, c.y, d.x, d.y}; }
                    v0 = v0 * sc; v1 = v1 * sc; u32x4 w; w.x = cvt_pk_bf16(v0[0], v0[1]); w.y = cvt_pk_bf16(v0[2], v0[3]); w.z = cvt_pk_bf16(v1[0], v1[1]); w.w = cvt_pk_bf16(v1[2], v1[3]);
                    *(u32x4*)(rowp + bj * HALF) = w; } }
    }
};

struct EpiBf16Part {
    static constexpr bool PERM = true, AFTER_DRAIN = false;
    bf16_t* O0; bf16_t* O1; int ldc;
    __device__ __forceinline__ void operator()(const f32x4 (&acc)[2][2][4][2], const Unit& u, int wr, int wc, int fr, int fq) const {
        const EpiBf16<0> e{u.part ? O1 : O0, ldc, nullptr, 0, 0, 1.f}; e(acc, u, wr, wc, fr, fq); }
};

struct PanelStats {
    unsigned* xbuf;
    unsigned* cnt;
    unsigned* tmo;
    int ntn; float eps;
    unsigned code;
    __device__ __forceinline__ bool run(const f32x4 (&v)[2][2][4][2], const Unit& u, int wr, int wc, int fr, int fq, PG8_LAS unsigned char* lds, int wid, int lane) const {
        typedef float f32x2v __attribute__((ext_vector_type(2)));
        PG8_LAS f32x2v* P = (PG8_LAS f32x2v*)lds;
        PG8_LAS f32x2v* S = (PG8_LAS f32x2v*)(lds + 8192);
        PG8_LAS unsigned* flag = (PG8_LAS unsigned*)(lds + 8192 + 2048);
#pragma unroll
        for (int ai = 0; ai < 2; ++ai)
#pragma unroll
            for (int m = 0; m < 4; ++m) {
                float s = 0.f;
#pragma unroll
                for (int bj = 0; bj < 2; ++bj)
#pragma unroll
                    for (int n = 0; n < 2; ++n) { const f32x4 x = v[ai][bj][m][n]; s += (x[0] + x[1]) + (x[2] + x[3]); }
                s += __shfl_xor(s, 16); s += __shfl_xor(s, 32);
                const float mw = s * (1.0f / 64.0f); float q = 0.f;
#pragma unroll
                for (int bj = 0; bj < 2; ++bj)
#pragma unroll
                    for (int n = 0; n < 2; ++n) { const f32x4 d = v[ai][bj][m][n] - mw; q += (d[0] * d[0] + d[1] * d[1]) + (d[2] * d[2] + d[3] * d[3]); }
                q += __shfl_xor(q, 16); q += __shfl_xor(q, 32);
                if (fq == 0) P[(ai * HALF + wr * 64 + m * 16 + fr) * 4 + wc] = (f32x2v){mw, q};
            }
        asm volatile("s_waitcnt lgkmcnt(0)" ::: "memory"); __builtin_amdgcn_s_barrier(); asm volatile("" ::: "memory");
#if defined(BROKEN_EXCHANGE_NO_WAIT)
#warning BROKEN CONTROL BUILD: the row-statistics exchange does not wait; results are wrong by design
        if (blockIdx.x >= 64) { const long long t0_ = clock64(); while (clock64() - t0_ < 60000) __builtin_amdgcn_s_sleep(8); }
#endif
        const int row = wid * 32 + (lane & 31);
        if (lane < 32) {
            const f32x2v a = P[row * 4 + 0], b = P[row * 4 + 1], c = P[row * 4 + 2], d = P[row * 4 + 3];
            const float mt = (a.x + b.x + c.x + d.x) * 0.25f;
            const float da = a.x - mt, db = b.x - mt, dc = c.x - mt, dd = d.x - mt;
            const float m2 = (a.y + b.y) + (c.y + d.y) + 64.0f * ((da * da + db * db) + (dc * dc + dd * dd));
            unsigned long long* slot = (unsigned long long*)xbuf + ((size_t)(u.pm * BM + row) * 4 + u.pn);
            __hip_atomic_store(slot, ((unsigned long long)__float_as_uint(m2) << 32) | __float_as_uint(mt), __ATOMIC_RELAXED, __HIP_MEMORY_SCOPE_AGENT);
        }
        asm volatile("s_waitcnt vmcnt(0)" ::: "memory");
        if (lane == 0) __hip_atomic_fetch_add(cnt + 64 * u.pm, 1u, __ATOMIC_RELAXED, __HIP_MEMORY_SCOPE_AGENT);
        if (wid == 0) {
            bool dead = false; const unsigned long long t0 = __builtin_amdgcn_s_memrealtime(); const unsigned want = 8u * (unsigned)ntn;
            for (;;) {
#if defined(BROKEN_EXCHANGE_NO_WAIT)
                break;
#endif
                if ((unsigned)__builtin_amdgcn_readfirstlane(__hip_atomic_load(cnt + 64 * u.pm, __ATOMIC_RELAXED, __HIP_MEMORY_SCOPE_AGENT)) >= want) break;
                if (__builtin_amdgcn_s_memrealtime() - t0 > 2000000ull) {
                    if (lane == 0) { unsigned expect = 0u; __hip_atomic_compare_exchange_strong(tmo + 1, &expect, code | (unsigned)(u.pm & 0xff), __ATOMIC_RELAXED, __ATOMIC_RELAXED, __HIP_MEMORY_SCOPE_AGENT);
                                     __hip_atomic_store(tmo, 1u, __ATOMIC_RELAXED, __HIP_MEMORY_SCOPE_AGENT); }
                    dead = true; break; }
                __builtin_amdgcn_s_sleep(2);
            }
            __builtin_amdgcn_fence(__ATOMIC_ACQUIRE, "agent");
            if (lane == 0) flag[0] = dead ? 1u : 0u;
        }
        asm volatile("s_waitcnt vmcnt(0) lgkmcnt(0)" ::: "memory"); __builtin_amdgcn_s_barrier(); asm volatile("" ::: "memory");
        const bool bad = flag[0] != 0u;
        if (lane < 32) {
            const unsigned long long* slot = (const unsigned long long*)xbuf + (size_t)(u.pm * BM + row) * 4; float mt[4], m2[4]; float ms = 0.f;
#pragma unroll
            for (int t = 0; t < 4; ++t) { if (t < ntn) { const unsigned long long w = __hip_atomic_load(slot + t, __ATOMIC_RELAXED, __HIP_MEMORY_SCOPE_AGENT); mt[t] = __uint_as_float((unsigned)w); m2[t] = __uint_as_float((unsigned)(w >> 32)); } else { mt[t] = 0.f; m2[t] = 0.f; } ms += mt[t]; }
            const float mean = ms / (float)ntn; float q = 0.f;
#pragma unroll
            for (int t = 0; t < 4; ++t) if (t < ntn) { const float dm = mt[t] - mean; q += m2[t] + 256.0f * dm * dm; }
            S[row] = (f32x2v){mean, 1.0f / sqrtf(q / (256.0f * (float)ntn) + eps)};
        }
        asm volatile("s_waitcnt lgkmcnt(0)" ::: "memory"); __builtin_amdgcn_s_barrier(); asm volatile("" ::: "memory");
        return bad;
    }
};
struct EpiLnRes {
    static constexpr bool PERM = false, AFTER_DRAIN = true;
    const float* base; float* out; int ldc; const float* bias; PanelStats st; unsigned poison;
    __device__ __forceinline__ void fused(f32x4 (&acc)[2][2][4][2], const Unit& u, int wr, int wc, int fr, int fq, PG8_LAS unsigned char* lds, int wid, int lane) const {
        typedef float f32x2v __attribute__((ext_vector_type(2)));
        const PG8_LAS f32x2v* S = (const PG8_LAS f32x2v*)(lds + 8192);
        const int col0 = u.pn * BM + wc * 32 + 4 * fq;
#pragma unroll
        for (int bj = 0; bj < 2; ++bj)
#pragma unroll
            for (int n = 0; n < 2; ++n) { const f32x4 bv = bias ? *(const f32x4*)(bias + col0 + bj * HALF + n * 16) : (f32x4){0.f, 0.f, 0.f, 0.f};
#pragma unroll
                for (int ai = 0; ai < 2; ++ai)
#pragma unroll
                    for (int m = 0; m < 4; ++m) acc[ai][bj][m][n] += bv; }
        f32x4 pre[4][2][2];
#pragma unroll
        for (int m = 0; m < 4; ++m) { const size_t off = (size_t)(u.pm * BM + wr * 64 + m * 16 + fr) * ldc + col0;
#pragma unroll
            for (int bj = 0; bj < 2; ++bj)
#pragma unroll
                for (int n = 0; n < 2; ++n) pre[m][bj][n] = *(const f32x4*)(base + off + bj * HALF + n * 16); }
        const bool bad = st.run(acc, u, wr, wc, fr, fq, lds, wid, lane) || poison != 0u;
        const float qnan = __builtin_nanf("");
#pragma unroll
        for (int ai = 0; ai < 2; ++ai)
#pragma unroll
            for (int m = 0; m < 4; ++m) { const int r = ai * HALF + wr * 64 + m * 16 + fr; const f32x2v sr = S[r]; const size_t off = (size_t)(u.pm * BM + r) * ldc + col0;
#pragma unroll
                for (int bj = 0; bj < 2; ++bj)
#pragma unroll
                    for (int n = 0; n < 2; ++n) { const f32x4 bs = ai == 0 ? pre[m][bj][n] : *(const f32x4*)(base + off + bj * HALF + n * 16); f32x4 o = bs + (acc[ai][bj][m][n] - sr.x) * sr.y;
                        if (bad) o = (f32x4){qnan, qnan, qnan, qnan}; *(f32x4*)(out + off + bj * HALF + n * 16) = o; }
                if (m & 1) asm volatile("" ::: "memory"); }
    }
};
struct EpiLnResLn {
    static constexpr bool PERM = false, AFTER_DRAIN = true;
    const float* base; float* out; bf16_t* xn; int ldc; const float* bias; PanelStats st1, st2; unsigned poison;
    __device__ __forceinline__ void fused(f32x4 (&acc)[2][2][4][2], const Unit& u, int wr, int wc, int fr, int fq, PG8_LAS unsigned char* lds, int wid, int lane) const {
        typedef float f32x2v __attribute__((ext_vector_type(2))); typedef unsigned u32x2v __attribute__((ext_vector_type(2)));
        const PG8_LAS f32x2v* S = (const PG8_LAS f32x2v*)(lds + 8192);
        const int col0 = u.pn * BM + wc * 32 + 4 * fq;
#pragma unroll
        for (int bj = 0; bj < 2; ++bj)
#pragma unroll
            for (int n = 0; n < 2; ++n) { const f32x4 bv = bias ? *(const f32x4*)(bias + col0 + bj * HALF + n * 16) : (f32x4){0.f, 0.f, 0.f, 0.f};
#pragma unroll
                for (int ai = 0; ai < 2; ++ai)
#pragma unroll
                    for (int m = 0; m < 4; ++m) acc[ai][bj][m][n] += bv; }
        bool bad = st1.run(acc, u, wr, wc, fr, fq, lds, wid, lane) || poison != 0u;
        const float qnan = __builtin_nanf("");
#pragma unroll
        for (int ai = 0; ai < 2; ++ai)
#pragma unroll
            for (int m = 0; m < 4; ++m) { const int r = ai * HALF + wr * 64 + m * 16 + fr; const f32x2v sr = S[r]; const size_t off = (size_t)(u.pm * BM + r) * ldc + col0;
#pragma unroll
                for (int bj = 0; bj < 2; ++bj)
#pragma unroll
                    for (int n = 0; n < 2; ++n) { const f32x4 bs = *(const f32x4*)(base + off + bj * HALF + n * 16); acc[ai][bj][m][n] = bs + (acc[ai][bj][m][n] - sr.x) * sr.y; }
                asm volatile("" : "+v"(acc[ai][0][m][0]), "+v"(acc[ai][0][m][1]), "+v"(acc[ai][1][m][0]), "+v"(acc[ai][1][m][1]));
                if (m & 1) asm volatile("" ::: "memory"); }
        const bool bad1 = bad;
        bad = st2.run(acc, u, wr, wc, fr, fq, lds, wid, lane) || bad;
#pragma unroll
        for (int ai = 0; ai < 2; ++ai)
#pragma unroll
            for (int m = 0; m < 4; ++m) { const int r = ai * HALF + wr * 64 + m * 16 + fr; const f32x2v sr = S[r]; const size_t off = (size_t)(u.pm * BM + r) * ldc + col0;
#pragma unroll
                for (int bj = 0; bj < 2; ++bj)
#pragma unroll
                    for (int n = 0; n < 2; ++n) { const f32x4 x1 = acc[ai][bj][m][n]; *(f32x4*)(out + off + bj * HALF + n * 16) = bad1 ? (f32x4){qnan, qnan, qnan, qnan} : x1;
                        const f32x4 o = (x1 - sr.x) * sr.y; u32x2v w; w.x = cvt_pk_bf16(o[0], o[1]); w.y = cvt_pk_bf16(o[2], o[3]);
                        if (bad) { w.x = 0x7fc07fc0u; w.y = 0x7fc07fc0u; } *(u32x2v*)(xn + off + bj * HALF + n * 16) = w; }
                asm volatile("" ::: "memory"); }
    }
};

template <class Epi, class Sched, bool ALIGN_EPI = false, bool SP2 = false>
__device__ __forceinline__ void gemm_phase(PG8_LAS unsigned char* lds, const Gemm g, const Sched& S, const Epi& E, const int tid) {
    const int wid = __builtin_amdgcn_readfirstlane(tid >> 6), lane = tid & 63, wr = wid >> 2, wc = wid & 3, fr = lane & 15, fq = lane >> 4;
    const int K = g.K; int nt = K / BK;
    unsigned voffA[2], voffB[2];
#pragma unroll
    for (int i = 0; i < 2; ++i) { int R, C; stage_rc(tid * 16 + i * 8192, R, C); const int Rb = Epi::PERM ? ((R & ~31) + perm32(R & 31)) : R;
        voffA[i] = (unsigned)(R * K + C) * 2u; voffB[i] = (unsigned)(Rb * K + C) * 2u; }
    const size_t kstep = (size_t)(BK * 2);
    const size_t hstep = (size_t)HALF * K * 2;
    const size_t tstep = 2 * hstep;
    const unsigned ldsw = (unsigned)wid * 1024u;
    const int aoff = lds_byte(wr * 64 + fr, fq * 8), boff = lds_byte(wc * 32 + fr, fq * 8);
#define PG8_SA(b, h) (((b) * 2 + (h)) * HTB)
#define PG8_SB(b, h) ((4 + (b) * 2 + (h)) * HTB)
#define PG8_STAGE(bufoff, gbase, voff) do { _Pragma("unroll") for (int _i = 0; _i < 2; ++_i) \
        __builtin_amdgcn_global_load_lds((const unsigned*)((const char*)(gbase) + (voff)[_i]), (PG8_LAS unsigned*)(lds + (bufoff) + ldsw + _i * 8192), 16, 0, 0); } while (0)
#define PG8_LDA(dst, b, h) do { _Pragma("unroll") for (int m = 0; m < 4; ++m) _Pragma("unroll") for (int k = 0; k < 2; ++k) dst[m][k] = *(const PG8_LAS bf16x8*)(lds + PG8_SA(b, h) + aoff + m * 2048 + k * 1024); } while (0)
#define PG8_LDB(dst, b, h) do { _Pragma("unroll") for (int n = 0; n < 2; ++n) _Pragma("unroll") for (int k = 0; k < 2; ++k) dst[n][k] = *(const PG8_LAS bf16x8*)(lds + PG8_SB(b, h) + boff + n * 2048 + k * 1024); } while (0)
#define PG8_MMA(ai, bj, At, Bt) do { __builtin_amdgcn_s_setprio(1); _Pragma("unroll") for (int m = 0; m < 4; ++m) _Pragma("unroll") for (int n = 0; n < 2; ++n) _Pragma("unroll") for (int k = 0; k < 2; ++k) \
        acc[ai][bj][m][n] = __builtin_amdgcn_mfma_f32_16x16x32_bf16(Bt[n][k], At[m][k], acc[ai][bj][m][n], 0, 0, 0); __builtin_amdgcn_s_setprio(0); } while (0)
#define PG8_WAIT_V(n) asm volatile("s_waitcnt vmcnt(" #n ")" ::: "memory")
#define PG8_WAIT_L(n) asm volatile("s_waitcnt lgkmcnt(" #n ")" ::: "memory")
#define PG8_BAR __builtin_amdgcn_s_barrier()
#define PG8_SCHED __builtin_amdgcn_sched_barrier(0)
    Unit cur, nxt; int ui = 0;
    if (!S.next(0, cur)) return;
    f32x4 acc[2][2][4][2];
#pragma unroll
    for (int a = 0; a < 2; ++a)
#pragma unroll
        for (int b = 0; b < 2; ++b)
#pragma unroll
            for (int m = 0; m < 4; ++m)
#pragma unroll
                for (int n = 0; n < 2; ++n) acc[a][b][m][n] = (f32x4){0.f, 0.f, 0.f, 0.f};
    bf16x8 At[4][2], B0[2][2], B1[2][2];
    const char* cA = (const char*)g.A + (size_t)cur.pm * tstep; const char* cB = (const char*)g.Bt + (size_t)cur.pn * tstep;
    if constexpr (Sched::SPLITK) { nt = cur.nt; cA += (size_t)cur.k0 * kstep; cB += (size_t)cur.k0 * kstep; }
    S.a_ready(cur);
    if constexpr (SP2) {
        PG8_STAGE(PG8_SB(0, 0), cB, voffB); PG8_STAGE(PG8_SB(0, 1), cB + hstep, voffB); PG8_STAGE(PG8_SA(0, 0), cA, voffA); PG8_STAGE(PG8_SA(0, 1), cA + hstep, voffA);
        if (wr == 1) PG8_BAR;
        PG8_WAIT_V(2); PG8_BAR;
        PG8_STAGE(PG8_SB(1, 0), cB + kstep, voffB); PG8_STAGE(PG8_SA(1, 0), cA + kstep, voffA); PG8_STAGE(PG8_SB(1, 1), cB + hstep + kstep, voffB);
        PG8_WAIT_V(6); PG8_BAR;
    } else {
        PG8_STAGE(PG8_SB(0, 0), cB, voffB); PG8_STAGE(PG8_SA(0, 0), cA, voffA); PG8_STAGE(PG8_SB(0, 1), cB + hstep, voffB); PG8_STAGE(PG8_SA(0, 1), cA + hstep, voffA);
        if (wr == 1) PG8_BAR;
        PG8_WAIT_V(4); PG8_BAR;
        PG8_STAGE(PG8_SB(1, 0), cB + kstep, voffB); PG8_STAGE(PG8_SA(1, 0), cA + kstep, voffA); PG8_STAGE(PG8_SB(1, 1), cB + hstep + kstep, voffB);
        PG8_WAIT_V(6); PG8_BAR;
    }
    for (;;) {
        const bool has_next = S.next(ui + 1, nxt);
        const char* nA = has_next ? (const char*)g.A + (size_t)nxt.pm * tstep : cA; const char* nB = has_next ? (const char*)g.Bt + (size_t)nxt.pn * tstep : cB;
        if constexpr (Sched::SPLITK) { if (has_next) { nA += (size_t)nxt.k0 * kstep; nB += (size_t)nxt.k0 * kstep; } }
        for (int t = 0; t < nt; t += 2) {
            const bool last = (t == nt - 2);
            const char* a1 = cA + (size_t)(t + 1) * kstep;
            const char* a2 = last ? nA : cA + (size_t)(t + 2) * kstep; const char* b2 = last ? nB : cB + (size_t)(t + 2) * kstep;
            const char* a3 = a2 + kstep; const char* b3 = b2 + kstep;
            if (last && has_next) S.a_ready(nxt);
            if constexpr (SP2) {
            PG8_LDB(B0, 0, 0); PG8_LDB(B1, 0, 1); PG8_SCHED; PG8_LDA(At, 0, 0); PG8_STAGE(PG8_SA(1, 1), a1 + hstep, voffA);
            PG8_WAIT_V(8); PG8_WAIT_L(0); PG8_BAR; PG8_MMA(0, 0, At, B0); PG8_MMA(0, 1, At, B1); PG8_BAR; PG8_SCHED;
            PG8_LDA(At, 0, 1); PG8_STAGE(PG8_SB(0, 0), b2, voffB); PG8_STAGE(PG8_SB(0, 1), b2 + hstep, voffB); PG8_STAGE(PG8_SA(0, 0), a2, voffA);
            PG8_WAIT_V(8); PG8_WAIT_L(0); PG8_BAR; PG8_MMA(1, 0, At, B0); PG8_MMA(1, 1, At, B1); PG8_BAR; PG8_SCHED;
            PG8_LDB(B0, 1, 0); PG8_LDB(B1, 1, 1); PG8_SCHED; PG8_LDA(At, 1, 0); PG8_STAGE(PG8_SA(0, 1), a2 + hstep, voffA);
            PG8_WAIT_V(8); PG8_WAIT_L(0); PG8_BAR; PG8_MMA(0, 0, At, B0); PG8_MMA(0, 1, At, B1); PG8_BAR; PG8_SCHED;
            PG8_LDA(At, 1, 1); PG8_STAGE(PG8_SB(1, 0), b3, voffB); PG8_STAGE(PG8_SB(1, 1), b3 + hstep, voffB); PG8_STAGE(PG8_SA(1, 0), a3, voffA);
            PG8_WAIT_V(8); PG8_WAIT_L(0); PG8_BAR; PG8_MMA(1, 0, At, B0); PG8_MMA(1, 1, At, B1); PG8_BAR; PG8_SCHED;
            } else {
            PG8_LDB(B0, 0, 0); PG8_SCHED; PG8_LDA(At, 0, 0); PG8_STAGE(PG8_SA(1, 1), a1 + hstep, voffA);
            PG8_WAIT_L(8); PG8_BAR; PG8_WAIT_L(0); PG8_MMA(0, 0, At, B0); PG8_BAR; PG8_SCHED;
            PG8_LDB(B1, 0, 1); PG8_STAGE(PG8_SB(0, 0), b2, voffB);
            PG8_BAR; PG8_WAIT_L(0); PG8_MMA(0, 1, At, B1); PG8_BAR;
            PG8_LDA(At, 0, 1); PG8_STAGE(PG8_SA(0, 0), a2, voffA);
            PG8_BAR; PG8_WAIT_L(0); PG8_MMA(1, 0, At, B0); PG8_BAR; PG8_SCHED;
            PG8_STAGE(PG8_SB(0, 1), b2 + hstep, voffB);
            PG8_WAIT_V(6); PG8_BAR; PG8_MMA(1, 1, At, B1); PG8_BAR;
            PG8_LDB(B0, 1, 0); PG8_SCHED; PG8_LDA(At, 1, 0); PG8_STAGE(PG8_SA(0, 1), a2 + hstep, voffA);
            PG8_WAIT_L(8); PG8_BAR; PG8_WAIT_L(0); PG8_MMA(0, 0, At, B0); PG8_BAR; PG8_SCHED;
            PG8_LDB(B1, 1, 1); PG8_STAGE(PG8_SB(1, 0), b3, voffB);
            PG8_BAR; PG8_WAIT_L(0); PG8_MMA(0, 1, At, B1); PG8_BAR;
            PG8_LDA(At, 1, 1); PG8_STAGE(PG8_SA(1, 0), a3, voffA);
            PG8_BAR; PG8_WAIT_L(0); PG8_MMA(1, 0, At, B0); PG8_BAR; PG8_SCHED;
            PG8_STAGE(PG8_SB(1, 1), b3 + hstep, voffB);
            PG8_WAIT_V(6); PG8_BAR; PG8_MMA(1, 1, At, B1); PG8_BAR;
            }
        }
        if constexpr (ALIGN_EPI) { if (wr == 0) PG8_BAR; }
        if constexpr (!Epi::AFTER_DRAIN) { E(acc, cur, wr, wc, fr, fq); S.done(cur); }
        if (!has_next) break;
#pragma unroll
        for (int a = 0; a < 2; ++a)
#pragma unroll
            for (int b = 0; b < 2; ++b)
#pragma unroll
                for (int m = 0; m < 4; ++m)
#pragma unroll
                    for (int n = 0; n < 2; ++n) acc[a][b][m][n] = (f32x4){0.f, 0.f, 0.f, 0.f};
        cur = nxt; cA = nA; cB = nB; ++ui; if constexpr (Sched::SPLITK) nt = cur.nt;
        if constexpr (ALIGN_EPI) { if (wr == 1) PG8_BAR; }
    }
    PG8_WAIT_V(0);
    if constexpr (!ALIGN_EPI) { if (wr == 0) PG8_BAR; }
    PG8_BAR;
    if constexpr (Epi::AFTER_DRAIN) { E.fused(acc, cur, wr, wc, fr, fq, lds, wid, lane); S.done(cur); }
#undef PG8_SA
#undef PG8_SB
#undef PG8_STAGE
#undef PG8_LDA
#undef PG8_LDB
#undef PG8_MMA
#undef PG8_WAIT_V
#undef PG8_WAIT_L
#undef PG8_BAR
#undef PG8_SCHED
}
}

#ifndef PG8_SP2
#define PG8_SP2 true
#endif
#ifndef PG8_ALIGN
#define PG8_ALIGN true
#endif

#define GAS __attribute__((address_space(1)))
#define LAS __attribute__((address_space(3)))
typedef unsigned short bf16;
typedef unsigned v4u __attribute__((ext_vector_type(4)));
typedef float f32x4 __attribute__((ext_vector_type(4)));
typedef short bf16x8 __attribute__((ext_vector_type(8)));
typedef GAS unsigned gu32;
typedef GAS unsigned long long gu64;
#define RLX_AGENT __ATOMIC_RELAXED, __HIP_MEMORY_SCOPE_AGENT
#define LDS_WAIT() asm volatile("s_waitcnt lgkmcnt(0)" ::: "memory")
#define VM_WAIT() asm volatile("s_waitcnt vmcnt(0)" ::: "memory")
__device__ __forceinline__ unsigned long long rt() { return __builtin_amdgcn_s_memrealtime(); }
__device__ __forceinline__ unsigned f2bf(float f) { unsigned u = __builtin_bit_cast(unsigned, f); return (u + 0x7fffu + ((u >> 16) & 1u)) >> 16; }
__device__ __forceinline__ unsigned pk2(float lo, float hi) { return f2bf(lo) | (f2bf(hi) << 16); }

#define XB_TMO      128
#define XB_XCNT(j)  (256  + 64 * (j))
#define XB_XSUB(j)  (1280 + 64 * (j))
#define XB_XGEN(j)  (2304 + 64 * (j))
#define XB_TOP      3328
#define XB_TOPGEN   3392
#define XCD_BAR_WORDS 3456
#define XB_SPIN_CAP (1u << 18)

__device__ __forceinline__ unsigned xb_ld(unsigned* p)              { return __hip_atomic_load(p, __ATOMIC_RELAXED, __HIP_MEMORY_SCOPE_AGENT); }
__device__ __forceinline__ unsigned xb_add(unsigned* p, unsigned v) { return __hip_atomic_fetch_add(p, v, __ATOMIC_RELAXED, __HIP_MEMORY_SCOPE_AGENT); }
__device__ __forceinline__ unsigned xb_xcc_id() { return (unsigned)__builtin_amdgcn_s_getreg((3 << 11) | 20) & 0xFu; }
#define XB_SPIN(cond, bar) do { unsigned _sp = 0; while (cond) { __builtin_amdgcn_s_sleep(1); \
    if ((++_sp & 255u) == 0u) { if (xb_ld(&(bar)[XB_TMO])) break; if (_sp > XB_SPIN_CAP) { atomicAdd(&(bar)[XB_TMO], 1u); break; } } } } while (0)

struct XcdBarrier {
    unsigned* bar; unsigned x;
    volatile LAS unsigned* st;
};

__device__ __forceinline__ XcdBarrier xcd_barrier_post(unsigned* bar, volatile LAS unsigned* st) {
    XcdBarrier b; b.bar = bar; b.x = xb_xcc_id(); b.st = st;
    if (threadIdx.x == 0) (void)xb_add(&bar[XB_XCNT(b.x)], 1u);
    return b;
}
__device__ __forceinline__ void xcd_barrier_complete(unsigned* bar, unsigned x, unsigned& nloc, unsigned& nx) {
    const unsigned G = gridDim.x * gridDim.y * gridDim.z;
    unsigned sum, cnt, mine, sp = 0u;
    for (;;) {
        sum = 0u; cnt = 0u; mine = 0u;
#pragma unroll
        for (unsigned j = 0; j < 16; ++j) { const unsigned c = xb_ld(&bar[XB_XCNT(j)]); sum += c; cnt += (c > 0u) ? 1u : 0u; mine = (j == x) ? c : mine; }
        if (sum == G) break;
        __builtin_amdgcn_s_sleep(1);
        if ((++sp & 255u) == 0u) { if (xb_ld(&bar[XB_TMO])) break; if (sp > XB_SPIN_CAP) { atomicAdd(&bar[XB_TMO], 1u); break; } }
    }
    nloc = mine > 0u ? mine : 1u; nx = cnt > 0u ? cnt : 1u;
}

__device__ __forceinline__ void xcd_barrier(const XcdBarrier& b, const int tid_) {
    asm volatile("s_waitcnt vmcnt(0)" ::: "memory");
    __syncthreads();
    if (tid_ == 0) {
        unsigned* bar = b.bar;
        __builtin_amdgcn_s_waitcnt(0);
        unsigned nloc = b.st[0], nx = b.st[1];
        if (nloc == 0u) { xcd_barrier_complete(bar, b.x, nloc, nx); b.st[0] = nloc; b.st[1] = nx; }
        const unsigned old = xb_add(&bar[XB_XSUB(b.x)], 1u);
        const unsigned gen = old / nloc;
        if (old + 1u == (gen + 1u) * nloc) {
            asm volatile("buffer_inv sc1" ::: "memory");
            __builtin_amdgcn_fence(__ATOMIC_RELEASE, "agent");
            asm volatile("s_waitcnt vmcnt(0)" ::: "memory");
            const unsigned og = xb_add(&bar[XB_TOP], 1u);
            const unsigned tg = og / nx;
            if (og + 1u == (tg + 1u) * nx) xb_add(&bar[XB_TOPGEN], 1u);
            else XB_SPIN(xb_ld(&bar[XB_TOPGEN]) == tg, bar);
            xb_add(&bar[XB_XGEN(b.x)], 1u);
            asm volatile("s_waitcnt vmcnt(0)" ::: "memory");
        } else {
            asm volatile("buffer_inv sc1" ::: "memory");
            XB_SPIN(xb_ld(&bar[XB_XGEN(b.x)]) == gen, bar);
            asm volatile("s_waitcnt vmcnt(0)" ::: "memory");
        }
    }
    __syncthreads();
}

namespace pg8 {
struct EpiF32 {
    static constexpr bool PERM = false, AFTER_DRAIN = false;
    float* O; int ldc;
    __device__ __forceinline__ void operator()(const f32x4 (&acc)[2][2][4][2], const Unit& u, int wr, int wc, int fr, int fq) const {
        const int row0 = u.pm * BM + wr * 64 + fr, col0 = u.pn * BM + wc * 32 + 4 * fq;
#pragma unroll
        for (int ai = 0; ai < 2; ++ai)
#pragma unroll
            for (int m = 0; m < 4; ++m) { float* rowp = O + (size_t)(row0 + ai * HALF + m * 16) * ldc + col0;
#pragma unroll
                for (int bj = 0; bj < 2; ++bj)
#pragma unroll
                    for (int n = 0; n < 2; ++n) *(f32x4*)(rowp + bj * HALF + n * 16) = acc[ai][bj][m][n]; }
    }
};
__device__ __forceinline__ float silu_f(float x) { return x * __builtin_amdgcn_rcpf(1.0f + __expf(-x)); }
struct EpiSwiGLU {
    static constexpr bool PERM = true, AFTER_DRAIN = false;
    bf16_t* O; int ldc;
    __device__ __forceinline__ void operator()(const f32x4 (&acc)[2][2][4][2], const Unit& u, int wr, int wc, int fr, int fq) const {
        const int row0 = u.pm * BM + wr * 64 + fr, col0 = u.pn * HALF + wc * 32 + 8 * fq;
#pragma unroll
        for (int ai = 0; ai < 2; ++ai)
#pragma unroll
            for (int m = 0; m < 4; ++m) { bf16_t* rowp = O + (size_t)(row0 + ai * HALF + m * 16) * ldc + col0;
                const f32x4 a0 = acc[ai][0][m][0], a1 = acc[ai][0][m][1], b0 = acc[ai][1][m][0], b1 = acc[ai][1][m][1];
                u32x4 w; w.x = cvt_pk_bf16(silu_f(a0[0]) * b0[0], silu_f(a0[1]) * b0[1]); w.y = cvt_pk_bf16(silu_f(a0[2]) * b0[2], silu_f(a0[3]) * b0[3]);
                w.z = cvt_pk_bf16(silu_f(a1[0]) * b1[0], silu_f(a1[1]) * b1[1]); w.w = cvt_pk_bf16(silu_f(a1[2]) * b1[2], silu_f(a1[3]) * b1[3]);
                *(u32x4*)rowp = w; }
    }
};
struct EpiP {
    static constexpr bool PERM = true, AFTER_DRAIN = false;
    bf16_t* Pm; bf16_t* Phy; int ldp; int mrows;
    __device__ __forceinline__ void operator()(const f32x4 (&acc)[2][2][4][2], const Unit& u, int wr, int wc, int fr, int fq) const {
        const int row0 = u.pm * BM + wr * 64 + fr; const int col0 = u.pn * BM + wc * 32 + 8 * fq;
        if (u.pn < 3) {
#pragma unroll
            for (int bj = 0; bj < 2; ++bj) { const int hcol = col0 + bj * HALF, pr = hcol / 24, j0 = hcol - pr * 24;
                bf16_t* base = Phy + ((size_t)pr * mrows + row0) * 24 + j0;
#pragma unroll
                for (int ai = 0; ai < 2; ++ai)
#pragma unroll
                    for (int m = 0; m < 4; ++m) { const f32x4 v0 = acc[ai][bj][m][0], v1 = acc[ai][bj][m][1];
                        u32x4 w; w.x = cvt_pk_bf16(v0[0], v0[1]); w.y = cvt_pk_bf16(v0[2], v0[3]); w.z = cvt_pk_bf16(v1[0], v1[1]); w.w = cvt_pk_bf16(v1[2], v1[3]);
                        *(u32x4*)(base + (size_t)(ai * HALF + m * 16) * 24) = w; } }
        } else {
#pragma unroll
            for (int ai = 0; ai < 2; ++ai)
#pragma unroll
                for (int m = 0; m < 4; ++m) { bf16_t* rowp = Pm + (size_t)(row0 + ai * HALF + m * 16) * ldp + (col0 - 768);
#pragma unroll
                    for (int bj = 0; bj < 2; ++bj) { const f32x4 v0 = acc[ai][bj][m][0], v1 = acc[ai][bj][m][1];
                        u32x4 w; w.x = cvt_pk_bf16(v0[0], v0[1]); w.y = cvt_pk_bf16(v0[2], v0[3]); w.z = cvt_pk_bf16(v1[0], v1[1]); w.w = cvt_pk_bf16(v1[2], v1[3]);
                        *(u32x4*)(rowp + bj * HALF) = w; } }
        }
    }
};

struct PanelRms {
    float* xbuf;
    unsigned* cnt;
    unsigned* tmo;
    float eps;
    __device__ __forceinline__ bool run(const f32x4 (&v)[2][2][4][2], const Unit& u, int wr, int wc, int fr, int fq, PG8_LAS unsigned char* lds, int wid, int lane) const {
        PG8_LAS float* P = (PG8_LAS float*)lds;
        PG8_LAS float* S = (PG8_LAS float*)(lds + 8192);
        PG8_LAS unsigned* flag = (PG8_LAS unsigned*)(lds + 8192 + 1024);
#pragma unroll
        for (int ai = 0; ai < 2; ++ai)
#pragma unroll
            for (int m = 0; m < 4; ++m) { float s = 0.f;
#pragma unroll
                for (int bj = 0; bj < 2; ++bj)
#pragma unroll
                    for (int n = 0; n < 2; ++n) { const f32x4 x = v[ai][bj][m][n]; s += (x[0] * x[0] + x[1] * x[1]) + (x[2] * x[2] + x[3] * x[3]); }
                s += __shfl_xor(s, 16); s += __shfl_xor(s, 32);
                if (fq == 0) P[(ai * HALF + wr * 64 + m * 16 + fr) * 4 + wc] = s; }
        asm volatile("s_waitcnt lgkmcnt(0)" ::: "memory"); __builtin_amdgcn_s_barrier(); asm volatile("" ::: "memory");
        const int row = wid * 32 + (lane & 31);
        if (lane < 32) { const float t = (P[row * 4 + 0] + P[row * 4 + 1]) + (P[row * 4 + 2] + P[row * 4 + 3]);
            __hip_atomic_store(xbuf + ((size_t)(u.pm * BM + row) * 4 + u.pn), t, __ATOMIC_RELAXED, __HIP_MEMORY_SCOPE_AGENT); }
        asm volatile("s_waitcnt vmcnt(0)" ::: "memory");
        if (lane == 0) __hip_atomic_fetch_add(cnt + 64 * u.pm, 1u, __ATOMIC_RELAXED, __HIP_MEMORY_SCOPE_AGENT);
        if (wid == 0) {
            bool dead = false; const unsigned long long t0 = __builtin_amdgcn_s_memrealtime();
            for (;;) {
                if ((unsigned)__builtin_amdgcn_readfirstlane(__hip_atomic_load(cnt + 64 * u.pm, __ATOMIC_RELAXED, __HIP_MEMORY_SCOPE_AGENT)) >= 32u) break;
                if (__builtin_amdgcn_s_memrealtime() - t0 > 2000000ull) { if (lane == 0) __hip_atomic_store(tmo, 1u, __ATOMIC_RELAXED, __HIP_MEMORY_SCOPE_AGENT); dead = true; break; }
                __builtin_amdgcn_s_sleep(2);
            }
            __builtin_amdgcn_fence(__ATOMIC_ACQUIRE, "agent");
            if (lane == 0) flag[0] = dead ? 1u : 0u;
        }
        asm volatile("s_waitcnt vmcnt(0) lgkmcnt(0)" ::: "memory"); __builtin_amdgcn_s_barrier(); asm volatile("" ::: "memory");
        const bool bad = flag[0] != 0u;
        if (lane < 32) { const float* slot = xbuf + (size_t)(u.pm * BM + row) * 4; float t = 0.f;
#pragma unroll
            for (int k = 0; k < 4; ++k) t += __hip_atomic_load(slot + k, __ATOMIC_RELAXED, __HIP_MEMORY_SCOPE_AGENT);
            S[row] = 1.0f / sqrtf(t * (1.0f / 1024.0f) + eps); }
        asm volatile("s_waitcnt lgkmcnt(0)" ::: "memory"); __builtin_amdgcn_s_barrier(); asm volatile("" ::: "memory");
        return bad;
    }
};
template <bool HAS_H, bool XB_IN, bool XB_OUT> struct EpiRes {
    static constexpr bool PERM = false, AFTER_DRAIN = true;
    const void* xprev_c; const void* xprev_s;
    void* xout; bf16_t* hout;
    const float* mod;
    const float* modh;
    int gate_off, sh_off;
    const float* gpost; const float* gpre;
    PanelRms st1, st2;
    __device__ __forceinline__ void fused(f32x4 (&acc)[2][2][4][2], const Unit& u, int wr, int wc, int fr, int fq, PG8_LAS unsigned char* lds, int wid, int lane) const {
        typedef unsigned u32x2v __attribute__((ext_vector_type(2)));
        const PG8_LAS float* S = (const PG8_LAS float*)(lds + 8192);
        const int col0 = u.pn * BM + wc * 32 + 4 * fq;
        const int cv = u.pm < 32 ? 0 : 1 + ((u.pm - 32) >> 2);
        const size_t prow = (size_t)(u.pm < 32 ? u.pm : u.pm - 32) * BM * 1024;
        const void* xpv = u.pm < 32 ? xprev_c : xprev_s;
        bool bad = st1.run(acc, u, wr, wc, fr, fq, lds, wid, lane);
        float sr[2][4];
#pragma unroll
        for (int ai = 0; ai < 2; ++ai)
#pragma unroll
            for (int m = 0; m < 4; ++m) sr[ai][m] = S[ai * HALF + wr * 64 + m * 16 + fr];
        const size_t roff = (size_t)(wr * 64 + fr) * 1024 + col0;
#pragma unroll
        for (int bj = 0; bj < 2; ++bj) {
            f32x4 gg[2];
#pragma unroll
            for (int n = 0; n < 2; ++n) { const int c = bj * HALF + n * 16; gg[n] = *(const f32x4*)(mod + (size_t)cv * 6144 + gate_off + col0 + c) * *(const f32x4*)(gpost + col0 + c); }
            if (XB_IN) {
                u32x2v bs[2][2][4];
#pragma unroll
                for (int n = 0; n < 2; ++n)
#pragma unroll
                    for (int ai = 0; ai < 2; ++ai)
#pragma unroll
                        for (int m = 0; m < 4; ++m) bs[n][ai][m] = *(const u32x2v*)((const bf16_t*)xpv + prow + roff + (size_t)(ai * HALF + m * 16) * 1024 + bj * HALF + n * 16);
#pragma unroll
                for (int n = 0; n < 2; ++n)
#pragma unroll
                    for (int ai = 0; ai < 2; ++ai)
#pragma unroll
                        for (int m = 0; m < 4; ++m) { const u32x2v b = bs[n][ai][m]; const f32x4 xv = (f32x4){__uint_as_float(b.x << 16), __uint_as_float(b.x & 0xffff0000u), __uint_as_float(b.y << 16), __uint_as_float(b.y & 0xffff0000u)};
                            acc[ai][bj][m][n] = xv + gg[n] * (acc[ai][bj][m][n] * sr[ai][m]); }
            } else {
#pragma unroll
                for (int n = 0; n < 2; ++n)
#pragma unroll
                    for (int ai = 0; ai < 2; ++ai) { f32x4 bs[4];
#pragma unroll
                        for (int m = 0; m < 4; ++m) bs[m] = *(const f32x4*)((const float*)xpv + prow + roff + (size_t)(ai * HALF + m * 16) * 1024 + bj * HALF + n * 16);
#pragma unroll
                        for (int m = 0; m < 4; ++m) acc[ai][bj][m][n] = bs[m] + gg[n] * (acc[ai][bj][m][n] * sr[ai][m]);
                        asm volatile("" : "+v"(acc[ai][bj][0][n]), "+v"(acc[ai][bj][1][n]), "+v"(acc[ai][bj][2][n]), "+v"(acc[ai][bj][3][n]));
                        asm volatile("" ::: "memory"); }
            }
            asm volatile("" : "+v"(acc[0][bj][0][0]), "+v"(acc[0][bj][1][0]), "+v"(acc[0][bj][2][0]), "+v"(acc[0][bj][3][0]), "+v"(acc[1][bj][0][0]), "+v"(acc[1][bj][1][0]), "+v"(acc[1][bj][2][0]), "+v"(acc[1][bj][3][0]));
            asm volatile("" : "+v"(acc[0][bj][0][1]), "+v"(acc[0][bj][1][1]), "+v"(acc[0][bj][2][1]), "+v"(acc[0][bj][3][1]), "+v"(acc[1][bj][0][1]), "+v"(acc[1][bj][1][1]), "+v"(acc[1][bj][2][1]), "+v"(acc[1][bj][3][1]));
            asm volatile("" ::: "memory");
        }
        const size_t orow = (size_t)(u.pm * BM) * 1024;
        if (HAS_H) {
            bad = st2.run(acc, u, wr, wc, fr, fq, lds, wid, lane) || bad;
#pragma unroll
            for (int ai = 0; ai < 2; ++ai)
#pragma unroll
                for (int m = 0; m < 4; ++m) sr[ai][m] = S[ai * HALF + wr * 64 + m * 16 + fr];
        }
#pragma unroll
        for (int bj = 0; bj < 2; ++bj)
#pragma unroll
            for (int n = 0; n < 2; ++n) { const int c = bj * HALF + n * 16;
                f32x4 sh = (f32x4){0.f, 0.f, 0.f, 0.f}, ga = sh;
                if (HAS_H) { sh = *(const f32x4*)(modh + (size_t)cv * 6144 + sh_off + col0 + c); ga = *(const f32x4*)(gpre + col0 + c) * (*(const f32x4*)(modh + (size_t)cv * 6144 + sh_off + 1024 + col0 + c) + 1.0f); }
#pragma unroll
                for (int ai = 0; ai < 2; ++ai)
#pragma unroll
                    for (int m = 0; m < 4; ++m) { const size_t off = orow + roff + (size_t)(ai * HALF + m * 16) * 1024 + c; const f32x4 x1 = acc[ai][bj][m][n];
                        if (XB_OUT) { u32x2v w; w.x = cvt_pk_bf16(x1[0], x1[1]); w.y = cvt_pk_bf16(x1[2], x1[3]); *(u32x2v*)((bf16_t*)xout + off) = w; }
                        else *(f32x4*)((float*)xout + off) = x1;
                        if (HAS_H) { const f32x4 o = (x1 * sr[ai][m]) * ga + sh; u32x2v w; w.x = cvt_pk_bf16(o[0], o[1]); w.y = cvt_pk_bf16(o[2], o[3]);
                            if (bad) { w.x = 0x7fc07fc0u; w.y = 0x7fc07fc0u; } *(u32x2v*)(hout + off) = w; } }
                asm volatile("" ::: "memory"); }
    }
};
}

constexpr int NWAVES = 8;
constexpr int NTHREADS = NWAVES * 64;
#ifndef PROBE_KIND
#define PROBE_KIND -1
#endif
#ifndef GLA_REP_A
#define GLA_REP_A 1
#endif
#ifndef GLA_REP_B
#define GLA_REP_B 1
#endif
#ifndef MK_PER_PHASE
#define MK_PER_PHASE 0
#endif
constexpr int D = 1024, NCTX = 8192, NSMP = 2048, M = NCTX + NSMP, DEPTH = 2;
constexpr int LC = 256, LS = 1024, NB_C = 32, NB_S = 2, GRIDW = 64;
constexpr int INC = 2848, INP = 3072, FF = 2816;
constexpr int LDP = 2304;
constexpr int OA = 0, OCc = 768, OBc = 1280;
constexpr float EPS = 1e-6f;
constexpr int NPHASE = 1 + 7 * DEPTH;

constexpr size_t MiB = 1u << 20;
constexpr size_t WS_CTL = 0, CTL_ZERO_BYTES = 1 * MiB;
constexpr size_t WS_MOD = 1 * MiB;
constexpr size_t WS_FILT = 2 * MiB;
constexpr size_t FILT_LAYER = 5 * MiB, FILT_S_OFF = 1 * MiB;
constexpr size_t WS_W = 12 * MiB, W_LAYER = 25 * MiB;
constexpr size_t W_IN = 0, W_OUT = 6 * MiB, W_13 = 8 * MiB, W_2 = 19 * MiB;
constexpr size_t WS_H = 62 * MiB;
constexpr size_t WS_P = 82 * MiB;
constexpr size_t WS_PHY = WS_P + 45 * MiB;
constexpr size_t WS_MIX = WS_H;
constexpr size_t WS_TBL = 202 * MiB, TBL_LAYER = 20 * MiB, TBL_S_OFF = 4 * MiB;
constexpr size_t WS_XB = 142 * MiB, WS_MF = 162 * MiB;
constexpr size_t WS_OF = 182 * MiB, WS_OB = 192 * MiB;
constexpr size_t WS_MF2 = 182 * MiB;
constexpr int G4_KTM = 30;
constexpr size_t WS_AGG = 242 * MiB;
constexpr size_t WS_XCH = 244 * MiB;
constexpr size_t XCH_BYTES = (size_t)M * 4 * 4;
constexpr size_t WS_END = 246 * MiB;
constexpr int CW_TMO = 0, CW_CODE = 1, CW_BAR = 4096, CW_GLAF = 65536, CW_MODRDY = 256, CW_QHEAD = 512, CW_SEAM = 16384, SEAM_BANK = 40 * 64;

constexpr int RING_OFF = 0, RING_BYTES = 131072;
constexpr int LDSCTL_OFF = RING_BYTES, MISC_OFF = LDSCTL_OFF + 320;
constexpr int LDS_BYTES = 163840;

struct Args { const float* in[32]; float* out; unsigned char* ws; int ph_lo, ph_hi, li, pad; };

__device__ __forceinline__ float bf2f(bf16 b) { return __uint_as_float((unsigned)b << 16); }
__device__ __forceinline__ float gelu_tanh(float x) { const float u = 0.7978845608028654f * (x + 0.044715f * x * x * x); return 0.5f * x * (1.0f + tanhf(u)); }
__device__ __forceinline__ float gelu_fast(float x) { const float u = 1.5957691216057308f * (x + 0.044715f * x * x * x); return x * __builtin_amdgcn_rcpf(1.0f + __expf(-u)); }
__device__ __forceinline__ float silu_fast(float x) { return x * __builtin_amdgcn_rcpf(1.0f + __expf(-x)); }
__device__ __forceinline__ float silu_acc(float x) { return x / (1.0f + expf(-x)); }
__device__ __forceinline__ float logsigmoid_f(float x) { return fminf(x, 0.f) - log1pf(expf(-fabsf(x))); }
__device__ __forceinline__ bf16x8 pack8(const float (&v)[8]) { v4u w; w.x = pk2(v[0], v[1]); w.y = pk2(v[2], v[3]); w.z = pk2(v[4], v[5]); w.w = pk2(v[6], v[7]); return __builtin_bit_cast(bf16x8, w); }
__device__ __forceinline__ float wave_sum(float v) {
#pragma unroll
    for (int o = 1; o < 64; o <<= 1) v += __shfl_xor(v, o);
    return v;
}

typedef float f32x4u __attribute__((ext_vector_type(4), aligned(4)));

#ifndef PROBE_T
#define PROBE_T -1
#endif
#ifndef PROBE_WG
#define PROBE_WG 40
#endif
#ifndef PROBE_K
#define PROBE_K 20
#endif
constexpr int CW_PT0 = 128, CW_PACC = 192;
__device__ __forceinline__ void probe_mark(unsigned char* ws, int id, bool begin, int wave, int lane_any) {
#if PROBE_T >= 0
    if (id == PROBE_T && (int)blockIdx.x == PROBE_WG && wave == 0) {
        const unsigned long long now = __builtin_amdgcn_s_memrealtime();
        if (__builtin_amdgcn_mbcnt_hi(~0u, __builtin_amdgcn_mbcnt_lo(~0u, 0u)) == 0u) {
            volatile unsigned long long* t0 = (volatile unsigned long long*)(ws + WS_CTL + CW_PT0 * 4); volatile unsigned long long* acc = (volatile unsigned long long*)(ws + WS_CTL + CW_PACC * 4);
            if (begin) *t0 = now; else *acc = *acc + (now - *t0); }
    }
#endif
}
__device__ __forceinline__ void probe_stretch(unsigned char* ws, int wave) {
#if PROBE_T >= 0
    if ((int)blockIdx.x == PROBE_WG && wave == 0) {
        volatile unsigned long long* acc = (volatile unsigned long long*)(ws + WS_CTL + CW_PACC * 4);
        const unsigned long long d = *acc * (unsigned long long)PROBE_K; const unsigned long long t0 = __builtin_amdgcn_s_memrealtime();
        while (__builtin_amdgcn_s_memrealtime() - t0 < d) __builtin_amdgcn_s_sleep(8);
    }
#endif
}
#define PMARK(id, b) probe_mark(a.ws, id, b, wave, 0)
#define LDS_BARRIER() do { asm volatile("s_waitcnt lgkmcnt(0)" ::: "memory"); __builtin_amdgcn_s_barrier(); asm volatile("" ::: "memory"); } while (0)
template <bool HYMAP = false>
__device__ __forceinline__ void p0_transpose_item(const float* W, int K, int N, bf16* WT, int k0, int n0, int drow0, LAS float* scr, int lane, int ch0 = 0) {
#pragma unroll 8
    for (int i = 0; i < 32; ++i) { const int kk = 2 * i + (lane >> 5); scr[kk * 33 + (lane & 31)] = W[(size_t)(k0 + kk) * N + n0 + (lane & 31)]; }
    LDS_WAIT(); asm volatile("" ::: "memory");
    const int c = lane & 7;
#pragma unroll
    for (int j = 0; j < 4; ++j) { const int n = (lane >> 3) + 8 * j; const LAS float* s = scr + (8 * c) * 33 + n;
        v4u o; o.x = pk2(s[0 * 33], s[1 * 33]); o.y = pk2(s[2 * 33], s[3 * 33]); o.z = pk2(s[4 * 33], s[5 * 33]); o.w = pk2(s[6 * 33], s[7 * 33]);
        const int drow = HYMAP ? (((ch0 + n) >> 2) * 12 + drow0 + ((ch0 + n) & 3)) : (drow0 + n);
        *(GAS v4u*)(WT + (size_t)drow * K + k0 + 8 * c) = o; }
    LDS_WAIT(); asm volatile("" ::: "memory");
}

__device__ __forceinline__ void p0_filter_item(const Args& a, int l, int path, int pblk, int q, LAS unsigned char* lds, int wave, int lane, int tid) {
    const int L = path ? LS : LC;
    float* T = (float*)(a.ws + WS_FILT + (size_t)l * FILT_LAYER + (path ? FILT_S_OFF : 0));
    const float* w1 = a.in[20] + (size_t)l * 17 * 64; const float* b1 = a.in[21] + l * 64; const float* fr = a.in[22] + l * 64;
    const float* w2 = a.in[23] + (size_t)l * 64 * 64; const float* b2 = a.in[24] + l * 64; const float* w3 = a.in[25] + (size_t)l * 64 * 1024;
    const float* ld = a.in[26] + (size_t)l * 1024; const float* hb = a.in[27] + (size_t)l * 512;
    LAS float* W3s = (LAS float*)lds;
    LAS float* scr = (LAS float*)(lds + 65536 + wave * 2048);
    LAS float* feat = scr;
    LAS float* h1 = scr + 80;
    LAS float* h2 = scr + 80 + 256;
    float w1v[17]; const float frq = fr[lane], bb1 = b1[lane], bb2 = b2[lane];
    {   f32x4 wv[8];
#pragma unroll
        for (int j = 0; j < 8; ++j) { const int u = tid + NTHREADS * j, i = u >> 6, c4 = u & 63; wv[j] = *(const GAS f32x4*)(w3 + (size_t)i * 1024 + q * 256 + 4 * c4); }
#pragma unroll
        for (int f = 0; f < 17; ++f) w1v[f] = w1[f * 64 + lane];
#pragma unroll
        for (int j = 0; j < 8; ++j) { const int u = tid + NTHREADS * j; *(LAS f32x4*)(W3s + 4 * u) = wv[j]; }
    }
    const int pb = pblk * 8 + wave;
    const float TWO_PI = 6.283185307179586f;
    if (lane < 17) {
#pragma unroll
        for (int p = 0; p < 4; ++p) { const int pos = pb * 4 + p; const float t = (float)pos / (float)(L - 1); const float om = TWO_PI * (float)pos / (float)L;
            float v;
            if (lane == 0) v = t;
            else { const int bi = (lane - 1) & 7; const float band = 1e-4f + (float)bi * ((7.0f - 1e-4f) / 7.0f); v = (lane <= 8) ? cosf(om * band) : sinf(om * band); }
            feat[p * 20 + lane] = v; }
    }
    LDS_WAIT(); asm volatile("" ::: "memory");
    {   float acc[4];
#pragma unroll
        for (int p = 0; p < 4; ++p) acc[p] = bb1;
#pragma unroll
        for (int f = 0; f < 17; ++f) {
#pragma unroll
            for (int p = 0; p < 4; ++p) acc[p] += feat[p * 20 + f] * w1v[f]; }
#pragma unroll
        for (int p = 0; p < 4; ++p) h1[p * 64 + lane] = __sinf(frq * acc[p]);
    }
    LDS_WAIT(); asm volatile("" ::: "memory");
    {   float acc[4];
#pragma unroll
        for (int p = 0; p < 4; ++p) acc[p] = bb2;
#pragma unroll 1
        for (int i0 = 0; i0 < 64; i0 += 32) { float wv[32];
#pragma unroll
            for (int i = 0; i < 32; ++i) wv[i] = w2[(i0 + i) * 64 + lane];
#pragma unroll
            for (int i = 0; i < 32; ++i)
#pragma unroll
                for (int p = 0; p < 4; ++p) acc[p] += h1[p * 64 + i0 + i] * wv[i]; }
#pragma unroll
        for (int p = 0; p < 4; ++p) h2[p * 64 + lane] = __sinf(frq * acc[p]);
    }
    __syncthreads();
    {   f32x4 acc[4];
#pragma unroll
        for (int p = 0; p < 4; ++p) acc[p] = (f32x4){0.f, 0.f, 0.f, 0.f};
#pragma unroll 8
        for (int i = 0; i < 64; ++i) { const f32x4 w = *(const LAS f32x4*)(W3s + i * 256 + 4 * lane);
#pragma unroll
            for (int p = 0; p < 4; ++p) acc[p] += w * h2[p * 64 + i]; }
        const int dir = q >> 1, o = q & 1;
        const f32x4 ldv = *(const f32x4*)(ld + q * 256 + 4 * lane);
        const f32x4 bv = *(const f32x4*)(hb + o * 256 + 4 * lane);
#pragma unroll
        for (int e = 0; e < 4; ++e) { const float rate = expf(ldv[e]); float v[4];
#pragma unroll
            for (int p = 0; p < 4; ++p) { const int pos = pb * 4 + p; const float t = (float)pos / (float)(L - 1); v[p] = acc[p][e] * __expf(-rate * t); }
            float* row = T + ((size_t)(o * 256 + 4 * lane + e)) * (2 * L);
            if (dir == 0) { if (pb == 0) { v[0] += bv[e]; row[0] = 0.f; }
                *(f32x4u*)(row + L - 4 * pb - 3) = (f32x4u){v[3], v[2], v[1], v[0]}; }
            else { if (pb == 0) { row[L + 1] = v[1]; row[L + 2] = v[2]; row[L + 3] = v[3]; } else *(f32x4*)(row + L + 4 * pb) = (f32x4){v[0], v[1], v[2], v[3]}; } }
    }
    __syncthreads();
}

__device__ __forceinline__ void p0_mod_item(const Args& a, int l, int cb, LAS float* sv  , LAS float* red  , int wave, int lane, int tid) {
    const float* wm = a.in[5] + (size_t)l * D * 6144; const float* bm = a.in[6] + (size_t)l * 6144;
    float* mod = (float*)(a.ws + WS_MOD) + (size_t)l * 3 * 6144;
    const int j0 = cb * 64 + 4 * (lane & 15), ks = lane >> 4;
    f32x4 wv[32];
#pragma unroll
    for (int i = 0; i < 32; ++i) wv[i] = *(const GAS f32x4*)(wm + (size_t)(wave * 128 + i * 4 + ks) * 6144 + j0);
    for (int i = tid; i < 3 * 1024; i += NTHREADS) { const int c = i >> 10, k = i & 1023; const float v = (c == 0) ? a.in[4][k] : a.in[3][(c - 1) * 1024 + k]; sv[i] = silu_acc(v); }
    __syncthreads();
    f32x4 acc[3];
#pragma unroll
    for (int c = 0; c < 3; ++c) acc[c] = (f32x4){0.f, 0.f, 0.f, 0.f};
#pragma unroll
    for (int i = 0; i < 32; ++i) { const int k = wave * 128 + i * 4 + ks;
#pragma unroll
        for (int c = 0; c < 3; ++c) acc[c] += wv[i] * sv[c * 1024 + k]; }
#pragma unroll
    for (int c = 0; c < 3; ++c)
#pragma unroll
        for (int e = 0; e < 4; ++e) { float v = acc[c][e]; v += __shfl_xor(v, 16); v += __shfl_xor(v, 32); acc[c][e] = v; }
    if (lane < 16) {
#pragma unroll
        for (int c = 0; c < 3; ++c)
#pragma unroll
            for (int e = 0; e < 4; ++e) red[(wave * 3 + c) * 64 + 4 * lane + e] = acc[c][e];
    }
    __syncthreads();
    if (tid < 192) { const int c = tid >> 6, j = tid & 63; float s = bm[cb * 64 + j];
#pragma unroll
        for (int w = 0; w < 8; ++w) s += red[(w * 3 + c) * 64 + j];
        const int col = cb * 64 + j, blk = col >> 10, k = col & 1023;
        if (blk == 1) s = (1.0f + s) * a.in[7][l * D + k]; else if (blk == 2) s *= a.in[8][l * D + k]; else if (blk == 4) s = (1.0f + s) * a.in[9][l * D + k]; else if (blk == 5) s *= a.in[10][l * D + k];
        mod[c * 6144 + col] = s; }
    __syncthreads();
}

constexpr int I_IN = 16 * 89, I_PAD = 224, I_OUT = 16 * 32, I_1 = 16 * 88, I_2 = 44 * 32;
constexpr int C_IN = I_IN + I_PAD, C_OUT = C_IN + I_OUT, C_13 = C_OUT + 2 * I_1, C_2 = C_13 + I_2;
__device__ __forceinline__ void convert_items(const Args& a, int l, int lo, int hi, int worker, int nworkers, LAS float* scr, int lane) {
    unsigned char* wl = a.ws + WS_W + (size_t)l * W_LAYER;
    for (int it = lo + worker; it < hi; it += nworkers) { int r = it;
        if (r < I_IN) { const int kb = r / 89, nb = r % 89, n0 = 32 * nb; const float* W = a.in[11] + (size_t)l * D * INC; bf16* WT = (bf16*)(wl + W_IN);
            if (n0 < 768) p0_transpose_item(W, D, INC, WT, 64 * kb, n0, 768 + n0, scr, lane);
            else if (n0 < 1568) p0_transpose_item(W, D, INC, WT, 64 * kb, n0, 2048 + (n0 - 768), scr, lane);
            else if (n0 < 2080) p0_transpose_item(W, D, INC, WT, 64 * kb, n0, 1536 + (n0 - 1568), scr, lane);
            else { const int cp = n0 - 2080; p0_transpose_item<true>(W, D, INC, WT, 64 * kb, n0, (cp >> 8) * 4, scr, lane, cp & 255); }
            continue; } r -= I_IN;
        if (r < I_PAD) { GAS v4u* dst = (GAS v4u*)((bf16*)(wl + W_IN) + (size_t)(INC + r) * D) + lane * 2; dst[0] = (v4u){0u, 0u, 0u, 0u}; dst[1] = (v4u){0u, 0u, 0u, 0u}; continue; } r -= I_PAD;
        if (r < I_OUT) { const int kb = r / 32, nb = r % 32; p0_transpose_item(a.in[28] + (size_t)l * D * D, D, D, (bf16*)(wl + W_OUT), 64 * kb, 32 * nb, 32 * nb, scr, lane); continue; } r -= I_OUT;
        if (r < I_1) { const int kb = r / 88, nb = r % 88, n0 = 32 * nb; p0_transpose_item(a.in[29] + (size_t)l * D * FF, D, FF, (bf16*)(wl + W_13), 64 * kb, n0, (n0 >> 7) * 256 + (n0 & 127), scr, lane); continue; } r -= I_1;
        if (r < I_1) { const int kb = r / 88, nb = r % 88, n0 = 32 * nb; p0_transpose_item(a.in[30] + (size_t)l * D * FF, D, FF, (bf16*)(wl + W_13), 64 * kb, n0, (n0 >> 7) * 256 + 128 + (n0 & 127), scr, lane); continue; } r -= I_1;
        { const int kb = r / 32, nb = r % 32; p0_transpose_item(a.in[31] + (size_t)l * FF * D, FF, D, (bf16*)(wl + W_2), 64 * kb, 32 * nb, 32 * nb, scr, lane); }
    }
}

__device__ __forceinline__ void row_phase(const Args& a, int l, int mode, int vcu, int G, int wave, int lane);
__device__ __forceinline__ void p0_prologue(const Args& a, LAS unsigned char* lds, int vcu, int G, int wave, int lane, int tid) {
    LAS float* scr = (LAS float*)(lds + RING_OFF + wave * 16384);
    PMARK(50, true);
    {
        LAS float* sv = (LAS float*)(lds + RING_OFF);
        LAS float* red = (LAS float*)(lds + RING_OFF + 12288);
        for (int it = vcu; it < 96; it += G) {
            p0_mod_item(a, 0, it, sv, red, wave, lane, tid);
            if (it < 32) {
                asm volatile("s_waitcnt vmcnt(0)" ::: "memory"); __syncthreads();
                if (tid == 0) { __builtin_amdgcn_fence(__ATOMIC_RELEASE, "agent"); asm volatile("s_waitcnt vmcnt(0)" ::: "memory"); __hip_atomic_fetch_add((gu32*)(a.ws + WS_CTL) + CW_MODRDY, 1u, __ATOMIC_RELAXED, __HIP_MEMORY_SCOPE_AGENT); } }
        }
        __syncthreads();
    }
    PMARK(50, false); PMARK(51, true);
    const int gw = vcu * NWAVES + wave, NGW = G * NWAVES;
    for (int it = vcu - 96; it >= 0 && it < 160; it += G) { const int blk = it >> 2, q = it & 3; if (blk < 32) p0_filter_item(a, 0, 1, blk, q, lds, wave, lane, tid); else p0_filter_item(a, 0, 0, blk - 32, q, lds, wave, lane, tid); }
    PMARK(51, false); PMARK(52, true);
    convert_items(a, 0, 0, C_IN, gw, NGW, scr, lane);
    PMARK(52, false); PMARK(53, true);
    if (wave == 0) { unsigned sp = 0;
        while (__hip_atomic_load((gu32*)(a.ws + WS_CTL) + CW_MODRDY, __ATOMIC_RELAXED, __HIP_MEMORY_SCOPE_AGENT) < 32u) { __builtin_amdgcn_s_sleep(2);
            if (++sp > (1u << 20)) { if (lane == 0) __hip_atomic_store((gu32*)(a.ws + WS_CTL) + CW_TMO, 1u, __ATOMIC_RELAXED, __HIP_MEMORY_SCOPE_AGENT); break; } }
        __builtin_amdgcn_fence(__ATOMIC_ACQUIRE, "agent"); asm volatile("s_waitcnt vmcnt(0)" ::: "memory"); }
    __syncthreads();
    row_phase(a, 0, 0, vcu, G, wave, lane);
    PMARK(53, false);
}

__device__ __forceinline__ void late_mod_item(const Args& a, int item, LAS unsigned char* lds, int wave, int lane, int tid) {
    p0_mod_item(a, 1, item, (LAS float*)(lds + RING_OFF), (LAS float*)(lds + RING_OFF + 12288), wave, lane, tid); }
__device__ __forceinline__ void late_filter_item(const Args& a, int it, LAS unsigned char* lds, int wave, int lane, int tid) {
    const int blk = it >> 2, q = it & 3; if (blk < 32) p0_filter_item(a, 1, 1, blk, q, lds, wave, lane, tid); else p0_filter_item(a, 1, 0, blk - 32, q, lds, wave, lane, tid); }
__device__ __forceinline__ void unpack8(const bf16x8 v, float (&o)[8]) {
#pragma unroll
    for (int e = 0; e < 8; ++e) o[e] = bf2f((bf16)v[e]);
}
template <int NQ>
__device__ __forceinline__ void row_pass(const Args& a, int l, int mode, int rbase, int rstride, int cv, int lane) {
    const bf16* MB = (const bf16*)(a.ws + WS_MF); bf16* XB = (bf16*)(a.ws + WS_XB); bf16* H = (bf16*)(a.ws + WS_H);
    const float* modb = (const float*)(a.ws + WS_MOD);
    const bool has_h = !(mode == 2 && l == DEPTH - 1);
    const bool m_split = (mode == 2 && l == DEPTH - 1);
    const bf16* MB2 = (const bf16*)(a.ws + WS_MF2);
    const bool x_in_f32 = (mode == 0) || (mode == 1 && l == 0);
    const bool x_out_f32 = (mode == 2 && l == DEPTH - 1);
    const int lh = (mode == 2) ? l + 1 : l;
    const int gate_blk = (mode == 1) ? 2 : 5, sh_blk = (mode == 1) ? 3 : 0;
    float x[NQ][2][8]; bf16x8 mraw[NQ][2], mraw2[NQ][2]; f32x4 gt[4], ga[4], sh[4];
#pragma unroll
    for (int q = 0; q < NQ; ++q) { const int r = rbase + q * rstride;
        if (mode != 0) {
#pragma unroll
            for (int j = 0; j < 2; ++j) { mraw[q][j] = *(const GAS bf16x8*)(MB + (size_t)r * D + 512 * j + 8 * lane); if (m_split) mraw2[q][j] = *(const GAS bf16x8*)(MB2 + (size_t)r * D + 512 * j + 8 * lane); } }
        if (x_in_f32) { const float* xp = (r < NCTX) ? a.in[0] + (size_t)r * D : a.in[1] + (size_t)(r - NCTX) * D;
#pragma unroll
            for (int j = 0; j < 2; ++j) { const f32x4 v0 = *(const GAS f32x4*)(xp + 512 * j + 8 * lane), v1 = *(const GAS f32x4*)(xp + 512 * j + 8 * lane + 4);
#pragma unroll
                for (int e = 0; e < 4; ++e) { x[q][j][e] = v0[e]; x[q][j][4 + e] = v1[e]; } } }
        else {
#pragma unroll
            for (int j = 0; j < 2; ++j) { const bf16x8 xr = *(const GAS bf16x8*)(XB + (size_t)r * D + 512 * j + 8 * lane); unpack8(xr, x[q][j]); } } }
    {   const float* mg = modb + ((size_t)l * 3 + cv) * 6144 + gate_blk * 1024; const float* mh = modb + ((size_t)(has_h ? lh : l) * 3 + cv) * 6144 + sh_blk * 1024;
#pragma unroll
        for (int j = 0; j < 2; ++j)
#pragma unroll
            for (int h4 = 0; h4 < 2; ++h4) { const int c = 512 * j + 8 * lane + 4 * h4;
                if (mode != 0) gt[2 * j + h4] = *(const GAS f32x4*)(mg + c);
                if (has_h) { sh[2 * j + h4] = *(const GAS f32x4*)(mh + c); ga[2 * j + h4] = *(const GAS f32x4*)(mh + 1024 + c); } } }
#pragma unroll
    for (int q = 0; q < NQ; ++q) { const int r = rbase + q * rstride;
        if (mode != 0) {
            float mv[2][8]; float s = 0.f;
#pragma unroll
            for (int j = 0; j < 2; ++j) { unpack8(mraw[q][j], mv[j]);
                if (m_split) { float m2[8]; unpack8(mraw2[q][j], m2);
#pragma unroll
                    for (int e = 0; e < 8; ++e) mv[j][e] += m2[e]; }
#pragma unroll
                for (int e = 0; e < 8; ++e) s += mv[j][e] * mv[j][e]; }
            const float rn = __builtin_amdgcn_rsqf(wave_sum(s) * (1.0f / D) + EPS);
#pragma unroll
            for (int j = 0; j < 2; ++j)
#pragma unroll
                for (int h4 = 0; h4 < 2; ++h4)
#pragma unroll
                    for (int e = 0; e < 4; ++e) x[q][j][4 * h4 + e] += gt[2 * j + h4][e] * (mv[j][4 * h4 + e] * rn);
            if (x_out_f32) {
#pragma unroll
                for (int j = 0; j < 2; ++j) { float* op = a.out + (size_t)r * D + 512 * j + 8 * lane; *(GAS f32x4*)op = (f32x4){x[q][j][0], x[q][j][1], x[q][j][2], x[q][j][3]}; *(GAS f32x4*)(op + 4) = (f32x4){x[q][j][4], x[q][j][5], x[q][j][6], x[q][j][7]}; } }
            else {
#pragma unroll
                for (int j = 0; j < 2; ++j) *(GAS bf16x8*)(XB + (size_t)r * D + 512 * j + 8 * lane) = pack8(x[q][j]); }
        }
        if (has_h) {
            float s = 0.f;
#pragma unroll
            for (int j = 0; j < 2; ++j)
#pragma unroll
                for (int e = 0; e < 8; ++e) s += x[q][j][e] * x[q][j][e];
            const float rn = __builtin_amdgcn_rsqf(wave_sum(s) * (1.0f / D) + EPS);
#pragma unroll
            for (int j = 0; j < 2; ++j) { float hv[8];
#pragma unroll
                for (int h4 = 0; h4 < 2; ++h4)
#pragma unroll
                    for (int e = 0; e < 4; ++e) hv[4 * h4 + e] = (x[q][j][4 * h4 + e] * rn) * ga[2 * j + h4][e] + sh[2 * j + h4][e];
                if (mode == 0) { const v4u hw = __builtin_bit_cast(v4u, pack8(hv)); asm volatile("global_store_dwordx4 %0, %1, off sc1\n\ts_nop 1" :: "v"(H + (size_t)r * D + 512 * j + 8 * lane), "v"(hw) : "memory"); }
                else *(GAS bf16x8*)(H + (size_t)r * D + 512 * j + 8 * lane) = pack8(hv); }
        }
    }
}
__device__ __forceinline__ void row_phase(const Args& a, int l, int mode, int vcu, int G, int wave, int lane) {
    const int gw = vcu * NWAVES + wave, NGW = G * NWAVES;
    if (NGW * 4 == NCTX && NGW * 5 == M) {
        row_pass<4>(a, l, mode, gw, NGW, 0, lane); row_pass<1>(a, l, mode, NCTX + gw, 0, 1 + (gw >> 10), lane); return; }
    const bf16* MB = (const bf16*)(a.ws + WS_MF); bf16* XB = (bf16*)(a.ws + WS_XB); bf16* H = (bf16*)(a.ws + WS_H);
    const float* modb = (const float*)(a.ws + WS_MOD);
    const bool has_h = !(mode == 2 && l == DEPTH - 1);
    const bool m_split = (mode == 2 && l == DEPTH - 1);
    const bf16* MB2 = (const bf16*)(a.ws + WS_MF2);
    const bool x_in_f32 = (mode == 0) || (mode == 1 && l == 0);
    const bool x_out_f32 = (mode == 2 && l == DEPTH - 1);
    const int lh = (mode == 2) ? l + 1 : l;
    const int gate_blk = (mode == 1) ? 2 : 5, sh_blk = (mode == 1) ? 3 : 0;
#pragma unroll 1
    for (int r0 = gw; r0 < M; r0 += 2 * NGW) {
        int rr[2]; bool ok[2]; rr[0] = r0; rr[1] = r0 + NGW; ok[0] = true; ok[1] = rr[1] < M; if (!ok[1]) rr[1] = r0;
        float x[2][2][8]; bf16x8 mraw[2][2], mraw2[2][2]; f32x4 gt[2][4], ga[2][4], sh[2][4];
#pragma unroll
        for (int q = 0; q < 2; ++q) { const int r = rr[q]; const int cv = (r < NCTX) ? 0 : 1 + ((r - NCTX) >> 10);
            if (mode != 0) {
#pragma unroll
                for (int j = 0; j < 2; ++j) { mraw[q][j] = *(const GAS bf16x8*)(MB + (size_t)r * D + 512 * j + 8 * lane); if (m_split) mraw2[q][j] = *(const GAS bf16x8*)(MB2 + (size_t)r * D + 512 * j + 8 * lane); } }
            if (x_in_f32) { const float* xp = (r < NCTX) ? a.in[0] + (size_t)r * D : a.in[1] + (size_t)(r - NCTX) * D;
#pragma unroll
                for (int j = 0; j < 2; ++j) { const f32x4 v0 = *(const GAS f32x4*)(xp + 512 * j + 8 * lane), v1 = *(const GAS f32x4*)(xp + 512 * j + 8 * lane + 4);
#pragma unroll
                    for (int e = 0; e < 4; ++e) { x[q][j][e] = v0[e]; x[q][j][4 + e] = v1[e]; } } }
            else {
#pragma unroll
                for (int j = 0; j < 2; ++j) { const bf16x8 xr = *(const GAS bf16x8*)(XB + (size_t)r * D + 512 * j + 8 * lane); unpack8(xr, x[q][j]); } }
            const float* mg = modb + ((size_t)l * 3 + cv) * 6144 + gate_blk * 1024; const float* mh = modb + ((size_t)(has_h ? lh : l) * 3 + cv) * 6144 + sh_blk * 1024;
#pragma unroll
            for (int j = 0; j < 2; ++j)
#pragma unroll
                for (int h4 = 0; h4 < 2; ++h4) { const int c = 512 * j + 8 * lane + 4 * h4;
                    if (mode != 0) gt[q][2 * j + h4] = *(const GAS f32x4*)(mg + c);
                    if (has_h) { sh[q][2 * j + h4] = *(const GAS f32x4*)(mh + c); ga[q][2 * j + h4] = *(const GAS f32x4*)(mh + 1024 + c); } } }
#pragma unroll
        for (int q = 0; q < 2; ++q) { const int r = rr[q];
            if (mode != 0) {
                float mv[2][8]; float s = 0.f;
#pragma unroll
                for (int j = 0; j < 2; ++j) { unpack8(mraw[q][j], mv[j]);
                    if (m_split) { float m2[8]; unpack8(mraw2[q][j], m2);
#pragma unroll
                        for (int e = 0; e < 8; ++e) mv[j][e] += m2[e]; }
#pragma unroll
                    for (int e = 0; e < 8; ++e) s += mv[j][e] * mv[j][e]; }
                const float rn = __builtin_amdgcn_rsqf(wave_sum(s) * (1.0f / D) + EPS);
#pragma unroll
                for (int j = 0; j < 2; ++j)
#pragma unroll
                    for (int h4 = 0; h4 < 2; ++h4)
#pragma unroll
                        for (int e = 0; e < 4; ++e) x[q][j][4 * h4 + e] += gt[q][2 * j + h4][e] * (mv[j][4 * h4 + e] * rn);
                if (ok[q]) {
                    if (x_out_f32) {
#pragma unroll
                        for (int j = 0; j < 2; ++j) { float* op = a.out + (size_t)r * D + 512 * j + 8 * lane; *(GAS f32x4*)op = (f32x4){x[q][j][0], x[q][j][1], x[q][j][2], x[q][j][3]}; *(GAS f32x4*)(op + 4) = (f32x4){x[q][j][4], x[q][j][5], x[q][j][6], x[q][j][7]}; } }
                    else {
#pragma unroll
                        for (int j = 0; j < 2; ++j) *(GAS bf16x8*)(XB + (size_t)r * D + 512 * j + 8 * lane) = pack8(x[q][j]); } }
            }
            if (has_h) {
                float s = 0.f;
#pragma unroll
                for (int j = 0; j < 2; ++j)
#pragma unroll
                    for (int e = 0; e < 8; ++e) s += x[q][j][e] * x[q][j][e];
                const float rn = __builtin_amdgcn_rsqf(wave_sum(s) * (1.0f / D) + EPS);
                if (ok[q]) {
#pragma unroll
                    for (int j = 0; j < 2; ++j) { float hv[8];
#pragma unroll
                        for (int h4 = 0; h4 < 2; ++h4)
#pragma unroll
                            for (int e = 0; e < 4; ++e) hv[4 * h4 + e] = (x[q][j][4 * h4 + e] * rn) * ga[q][2 * j + h4][e] + sh[q][2 * j + h4][e];
                        *(GAS bf16x8*)(H + (size_t)r * D + 512 * j + 8 * lane) = pack8(hv); } }
            }
        }
    }
}

__device__ __forceinline__ void p1_table_phase(const Args& a, int vcu, int G, int wave, int lane) {
    const int gw = vcu * NWAVES + wave, NGW = G * NWAVES;
    for (int it = gw; it < DEPTH * 512 * 5; it += NGW) {
        const int path = it < DEPTH * 2048 ? 1 : 0; const int r = path ? it : it - DEPTH * 2048;
        const int l = path ? (r >> 11) : (r >> 9), oc = path ? ((r >> 2) & 511) : (r & 511), mq = path ? (r & 3) : 0;
        const int L = path ? LS : LC;
        const float* Rp = (const float*)(a.ws + WS_FILT + (size_t)l * FILT_LAYER + (path ? FILT_S_OFF : 0)) + (size_t)oc * (2 * L);
        bf16* tb = (bf16*)(a.ws + WS_TBL + (size_t)l * TBL_LAYER + (path ? TBL_S_OFF : 0)) + (size_t)oc * (16 * L);
#pragma unroll 1
        for (int i0 = 0; i0 < 8; i0 += 4) {
            f32x4u va[4], vb[4]; int mm[4], jj[4];
#pragma unroll
            for (int i = 0; i < 4; ++i) { const int task = lane + 64 * (i0 + i); mm[i] = path ? 2 * mq + (task >> 8) : (task >> 6); jj[i] = path ? (task & 255) : (task & 63);
                const int y0 = 8 * jj[i] + mm[i];
                if (y0 + 8 <= 2 * L) { va[i] = *(const f32x4u*)(Rp + y0); vb[i] = *(const f32x4u*)(Rp + y0 + 4); }
                else {
#pragma unroll
                    for (int e = 0; e < 4; ++e) { va[i][e] = (y0 + e < 2 * L) ? Rp[y0 + e] : 0.f; vb[i][e] = (y0 + 4 + e < 2 * L) ? Rp[y0 + 4 + e] : 0.f; } } }
#pragma unroll
            for (int i = 0; i < 4; ++i) { v4u o; o.x = pk2(va[i][0], va[i][1]); o.y = pk2(va[i][2], va[i][3]); o.z = pk2(vb[i][0], vb[i][1]); o.w = pk2(vb[i][2], vb[i][3]);
                *(GAS v4u*)(tb + (size_t)mm[i] * (2 * L) + 8 * jj[i]) = o; }
        }
    }
}

template <int PATH>
__device__ __forceinline__ void hyena_mfma_item(const Args& a, int l, int item, LAS unsigned char* lds, int tid, int wave) {
    constexpr int L = PATH ? LS : LC, NROW = PATH ? 2 : 16, NT = NROW * L;
    constexpr int ZLEN = PATH ? 3760 : 264, ZOFF = PATH ? 1240 : 0, XLEN = PATH ? 1024 : 264;
#define ZIDX(t) (PATH ? (ZOFF + ((t) >> 5) * 40 + ((t) & 31)) : (t))
    constexpr int Z_BYTES = 4 * NROW * ZLEN * 2, X_BYTES = 4 * NROW * XLEN * 2;
    constexpr int TBC = L * 4, TB_BYTES = 4 * 2 * TBC;
    static_assert(Z_BYTES + 2 * X_BYTES + TB_BYTES <= RING_BYTES && NT * 8 <= X_BYTES, "hyena LDS map");
    LAS unsigned* TBs = (LAS unsigned*)(lds + Z_BYTES + 2 * X_BYTES);
    LAS bf16* Zs = (LAS bf16*)lds; LAS bf16* X1s = (LAS bf16*)(lds + Z_BYTES); LAS bf16* X2s = (LAS bf16*)(lds + Z_BYTES + X_BYTES);
    LAS bf16* OUTs = X1s;
    const int cb = PATH ? item : (item & 63); const int rowbase = PATH ? NCTX : (item >> 6) * 16 * LC;
    const bf16* PH = (const bf16*)(a.ws + WS_PHY) + ((size_t)(cb >> 1) * M + rowbase) * 24 + (cb & 1) * 12; bf16* MIX = (bf16*)(a.ws + WS_MIX);
    const float* cw = a.in[19] + (size_t)l * 3 * 768;
    const int lane = tid & 63, r = lane & 15, qd = lane >> 4;
    PMARK(30 + 10 * PATH, true); PMARK(31 + 10 * PATH, true);
    if (PATH) {
        for (int u = tid; u < 8 * ZLEN / 8; u += NTHREADS) *(LAS v4u*)(Zs + u * 8) = (v4u){0u, 0u, 0u, 0u};
        LDS_BARRIER(); }
    {   float w0[3][4], w1[3][4], w2[3][4];
#pragma unroll
        for (int part = 0; part < 3; ++part)
#pragma unroll
            for (int cc = 0; cc < 4; ++cc) { const int col = part * 256 + 4 * cb + cc; w0[part][cc] = cw[col]; w1[part][cc] = cw[768 + col]; w2[part][cc] = cw[1536 + col]; }
        constexpr int NI = NT / NTHREADS;
#pragma unroll 1
        for (int i0 = 0; i0 < NI; i0 += 4) {
            unsigned long long cm[4][3], lm[4][3], rm[4][3];
#pragma unroll
            for (int ii = 0; ii < 4; ++ii) { const int n = tid + NTHREADS * (i0 + ii); const int t = n & (L - 1); const int wpos = PATH ? (t & (GRIDW - 1)) : t; const bool hl = wpos > 0, hr = wpos < (PATH ? GRIDW : LC) - 1;
                const bf16* p = PH + (size_t)n * 24;
#pragma unroll
                for (int part = 0; part < 3; ++part) { cm[ii][part] = *(const GAS unsigned long long*)(p + 4 * part); lm[ii][part] = hl ? *(const GAS unsigned long long*)(p - 24 + 4 * part) : 0ull; rm[ii][part] = hr ? *(const GAS unsigned long long*)(p + 24 + 4 * part) : 0ull; } }
#pragma unroll
            for (int ii = 0; ii < 4; ++ii) { const int n = tid + NTHREADS * (i0 + ii); const int bb = n / L, t = n - bb * L;
#pragma unroll
                for (int part = 0; part < 3; ++part) {
                    LAS bf16* dst = (part == 0 ? X1s : (part == 1 ? X2s : Zs)) + (size_t)bb * (part == 2 ? ZLEN : XLEN) + (part == 2 ? ZIDX(t) : t);
                    const int cstride = NROW * (part == 2 ? ZLEN : XLEN);
#pragma unroll
                    for (int cc = 0; cc < 4; ++cc) { const float v = w1[part][cc] * bf2f((bf16)(cm[ii][part] >> (16 * cc))) + w0[part][cc] * bf2f((bf16)(lm[ii][part] >> (16 * cc))) + w2[part][cc] * bf2f((bf16)(rm[ii][part] >> (16 * cc)));
                        dst[cc * cstride] = (bf16)f2bf(v); } } }
        }
    }
    LDS_BARRIER();
    PMARK(31 + 10 * PATH, false); PMARK(32 + 10 * PATH, true);
    const int cc = wave >> 1, half = wave & 1;
    const int pcopy = r & 1;
    const int lane_dw = pcopy * L + ((L - r + 8 * qd - pcopy) >> 1);
#pragma unroll 1
    for (int o = 0; o < 2; ++o) {
        PMARK(34 + 10 * PATH, true);
        {
            const float* Rp = (const float*)(a.ws + WS_FILT + (size_t)l * FILT_LAYER + (PATH ? FILT_S_OFF : 0)) + (size_t)(o * 256 + 4 * cb) * (2 * L);
            for (int u = tid; u < L; u += NTHREADS) { const int ch = u / (L / 4), j0 = 4 * (u - ch * (L / 4)); const float* rp = Rp + (size_t)ch * (2 * L) + 2 * j0;
                const f32x4 v0 = *(const GAS f32x4*)rp, v1 = *(const GAS f32x4*)(rp + 4); const float v8 = (2 * j0 + 8 < 2 * L) ? rp[8] : 0.f;
                v4u c0, c1; c0.x = pk2(v0[0], v0[1]); c0.y = pk2(v0[2], v0[3]); c0.z = pk2(v1[0], v1[1]); c0.w = pk2(v1[2], v1[3]);
                c1.x = pk2(v0[1], v0[2]); c1.y = pk2(v0[3], v1[0]); c1.z = pk2(v1[1], v1[2]); c1.w = pk2(v1[3], v8);
                *(LAS v4u*)(TBs + (ch * 2 + 0) * L + j0) = c0; *(LAS v4u*)(TBs + (ch * 2 + 1) * L + j0) = c1; }
        }
        LDS_BARRIER();
        PMARK(34 + 10 * PATH, false); PMARK(35 + 10 * PATH, true);
        const LAS unsigned* tb = TBs + cc * 2 * L + lane_dw;
        const LAS bf16* Xg = (o == 0 ? X1s : X2s) + (size_t)cc * NROW * XLEN;
        LAS bf16* Zc = Zs + (size_t)cc * NROW * ZLEN;
        if (!PATH) {
            bf16x8 afr[22];
#pragma unroll
            for (int u = 0; u < 22; ++u) { const LAS unsigned* q = tb - (128 * half + 16 * (u - 14)) / 2; v4u w; w.x = q[0]; w.y = q[1]; w.z = q[2]; w.w = q[3]; afr[u] = __builtin_bit_cast(bf16x8, w); }
            f32x4 acc[8];
#pragma unroll
            for (int tt = 0; tt < 8; ++tt) acc[tt] = (f32x4){0.f, 0.f, 0.f, 0.f};
#pragma unroll
            for (int kj = 0; kj < 8; ++kj) { const bf16x8 bfr = *(const LAS bf16x8*)(Zc + r * ZLEN + 32 * kj + 8 * qd);
#pragma unroll
                for (int tt = 0; tt < 8; ++tt) acc[tt] = __builtin_amdgcn_mfma_f32_16x16x32_bf16(afr[tt - 2 * kj + 14], bfr, acc[tt], 0, 0, 0); }
            asm volatile("" : "+v"(acc[0]), "+v"(acc[7])); PMARK(35 + 10 * PATH, false); PMARK(36 + 10 * PATH, true);
            LDS_BARRIER();
#pragma unroll
            for (int tt = 0; tt < 8; ++tt) { const int t0 = 16 * (8 * half + tt) + 4 * qd; const unsigned long long gm = *(const LAS unsigned long long*)(Xg + r * XLEN + t0);
                float v[4];
#pragma unroll
                for (int e = 0; e < 4; ++e) v[e] = bf2f((bf16)(gm >> (16 * e))) * acc[tt][e];
                if (o == 0) *(LAS unsigned long long*)(Zc + r * ZLEN + t0) = (unsigned long long)pk2(v[0], v[1]) | ((unsigned long long)pk2(v[2], v[3]) << 32);
                else {
#pragma unroll
                    for (int e = 0; e < 4; ++e) OUTs[(size_t)(r * L + t0 + e) * 4 + cc] = (bf16)f2bf(v[e]); } }
        } else {
            f32x4 acc[2][2];
#pragma unroll
            for (int pt = 0; pt < 2; ++pt)
#pragma unroll
                for (int ih = 0; ih < 2; ++ih) acc[pt][ih] = (f32x4){0.f, 0.f, 0.f, 0.f};
            const LAS bf16* Zb = Zc + half * ZLEN + (31 + r) * 40 + 8 * qd;
#define HY_STEP(d, DO0, DO1) do { const LAS unsigned* q0 = tb - (32 * (d)) / 2; v4u w0, w1; w0.x = q0[0]; w0.y = q0[1]; w0.z = q0[2]; w0.w = q0[3]; w1.x = q0[-8]; w1.y = q0[-7]; w1.z = q0[-6]; w1.w = q0[-5]; \
                const bf16x8 a0 = __builtin_bit_cast(bf16x8, w0), a1 = __builtin_bit_cast(bf16x8, w1); \
                if (DO0) { const bf16x8 b0 = *(const LAS bf16x8*)(Zb - (d) * 40); acc[0][0] = __builtin_amdgcn_mfma_f32_16x16x32_bf16(a0, b0, acc[0][0], 0, 0, 0); acc[1][0] = __builtin_amdgcn_mfma_f32_16x16x32_bf16(a1, b0, acc[1][0], 0, 0, 0); } \
                if (DO1) { const bf16x8 b1 = *(const LAS bf16x8*)(Zb + (16 - (d)) * 40); acc[0][1] = __builtin_amdgcn_mfma_f32_16x16x32_bf16(a0, b1, acc[0][1], 0, 0, 0); acc[1][1] = __builtin_amdgcn_mfma_f32_16x16x32_bf16(a1, b1, acc[1][1], 0, 0, 0); } } while (0)
#pragma unroll 2
            for (int d = -31; d <= -16; ++d) HY_STEP(d, true, false);
#pragma unroll 1
            for (int d = -15; d <= 15; ++d) HY_STEP(d, true, true);
#pragma unroll 2
            for (int d = 16; d <= 31; ++d) HY_STEP(d, false, true);
#undef HY_STEP
            asm volatile("" : "+v"(acc[0][0]), "+v"(acc[1][1])); PMARK(35 + 10 * PATH, false); PMARK(36 + 10 * PATH, true);
            LDS_BARRIER();
#pragma unroll
            for (int pt = 0; pt < 2; ++pt)
#pragma unroll
                for (int ih = 0; ih < 2; ++ih) { const int bb = half, t0 = 32 * (16 * ih + r) + 16 * pt + 4 * qd; const unsigned long long gm = *(const LAS unsigned long long*)(Xg + bb * XLEN + t0);
                    float v[4];
#pragma unroll
                    for (int e = 0; e < 4; ++e) v[e] = bf2f((bf16)(gm >> (16 * e))) * acc[pt][ih][e];
                    if (o == 0) *(LAS unsigned long long*)(Zc + bb * ZLEN + ZIDX(t0)) = (unsigned long long)pk2(v[0], v[1]) | ((unsigned long long)pk2(v[2], v[3]) << 32);
                    else {
#pragma unroll
                        for (int e = 0; e < 4; ++e) OUTs[(size_t)(bb * L + t0 + e) * 4 + cc] = (bf16)f2bf(v[e]); } }
        }
        LDS_BARRIER();
        PMARK(36 + 10 * PATH, false);
    }
    PMARK(32 + 10 * PATH, false); PMARK(33 + 10 * PATH, true);
    for (int n = tid; n < NT; n += NTHREADS) *(GAS unsigned long long*)(MIX + (size_t)(rowbase + n) * D + 768 + 4 * cb) = *(const LAS unsigned long long*)(OUTs + (size_t)n * 4);
    LDS_BARRIER();
    PMARK(33 + 10 * PATH, false); PMARK(30 + 10 * PATH, false);
#undef ZIDX
}

__device__ __forceinline__ int ba_row0(int ba) { return ba < 2 ? NCTX + ba * LS : (ba - 2) * LC; }

template <int CTRL> __device__ __forceinline__ float dpp_f(float x) { return __int_as_float(__builtin_amdgcn_update_dpp(0, __float_as_int(x), CTRL, 0xf, 0xf, true)); }
__device__ __forceinline__ float bperm_f(int src_lane, float v) { return __int_as_float(__builtin_amdgcn_ds_bpermute(src_lane << 2, __float_as_int(v))); }
__device__ __forceinline__ float row16_sum(float v) {
    v += dpp_f<0xB1>(v); v += dpp_f<0x4E>(v); v += dpp_f<0x141>(v); v += dpp_f<0x140>(v); return v; }
constexpr int GLA_SRUN_OFF = LDSCTL_OFF + 1024;
__device__ __forceinline__ float fast_logsigmoid(float x) { return fminf(x, 0.f) - __logf(1.0f + __expf(-fabsf(x))); }
__device__ __forceinline__ void gla_mfma_item(const Args& a, int l, int ba, int h, int q, LAS unsigned char* lds, int tid_item, int wave) {
    constexpr int L = 256, NC = 4, rounds = 1; const int row0 = ba_row0(ba) + 256 * q;
    const int dir = wave & 1, n = wave >> 1;
    int tid = tid_item; int lane = tid & 63, r = lane & 15, qd = lane >> 4;
    LAS unsigned char* reg = lds + wave * 16384;
    LAS bf16* VT = (LAS bf16*)reg;
    LAS float* Ureg = (LAS float*)reg;
    LAS bf16* KT = (LAS bf16*)(reg + 9216);
    LAS float* WQ = (LAS float*)(reg + 13824);
    LAS float* VTOT = (LAS float*)(reg + 15872);
    LAS float* VSC = (LAS float*)(reg + 16000);
    LAS float* SRUN = (LAS float*)(lds + GLA_SRUN_OFF);
    PMARK(1, true); PMARK(2, true);
    for (int u = tid; u < 2 * 2048; u += NTHREADS) SRUN[u] = 0.f;
    {   const float* wg = a.in[13] + ((size_t)l * 2 + dir) * 16 * 128 + h * 32; float wv[8];
#pragma unroll
        for (int i = 0; i < 8; ++i) { const int u = lane + 64 * i, q4 = u >> 7, rr = (u >> 3) & 15, e = u & 7; wv[i] = wg[rr * 128 + 8 * q4 + e]; }
#pragma unroll
        for (int i = 0; i < 8; ++i) WQ[lane + 64 * i] = wv[i]; }
    LDS_BARRIER();
    const float qscale = 0.17677669529663687f;
#pragma unroll 1
    for (int rd = 0; rd < rounds; ++rd) {
        { int zz_ = rd; asm volatile("" : "+s"(zz_)); lane = (int)__builtin_amdgcn_mbcnt_hi(~0u, __builtin_amdgcn_mbcnt_lo(~0u, (unsigned)(zz_ - rd))); tid = wave * 64 + lane; r = lane & 15; qd = lane >> 4; }
        const int cidx = dir ? NC - 1 - (4 * rd + n) : 4 * rd + n; const int rowc = row0 + 64 * cidx;
        const int tsgn = dir ? -1 : 1, tbase = dir ? rowc + 63 : rowc;
        size_t zoff = 0; asm volatile("" : "+s"(zoff));
        const bf16* P = (const bf16*)(a.ws + WS_P + zoff);
        float bias[8];
        {   const float* bp = a.in[14] + ((size_t)l * 2 + dir) * 128 + h * 32 + 8 * qd + zoff; const f32x4 b0 = *(const GAS f32x4*)bp, b1 = *(const GAS f32x4*)(bp + 4);
#pragma unroll
            for (int e = 0; e < 4; ++e) { bias[e] = b0[e]; bias[4 + e] = b1[e]; } }
        PMARK(2, false); PMARK(3, true);
        bf16x8 qf[4], kf[4];
        float refv[8], totv[8];
        {
            float la[4][8];
            {
                bf16x8 g0[4], g1[4], vv[8];
#pragma unroll
                for (int mt = 0; mt < 4; ++mt) { const bf16* prow = P + (size_t)(tbase + tsgn * (16 * mt + r)) * LDP + OBc; g0[mt] = *(const GAS bf16x8*)(prow + 768 + dir * 16); g1[mt] = *(const GAS bf16x8*)(prow + 768 + dir * 16 + 8); }
                {
                    const bf16* vbase = P + OBc + 256 + h * 64 + 8 * (lane & 7);
#pragma unroll
                    for (int c8 = 0; c8 < 8; ++c8) vv[c8] = *(const GAS bf16x8*)(vbase + (size_t)(tbase + tsgn * (8 * c8 + (lane >> 3))) * LDP); }
                asm volatile("" : "+v"(g0[0]), "+v"(g0[1]), "+v"(g0[2]), "+v"(g0[3]), "+v"(g1[0]), "+v"(g1[1]), "+v"(g1[2]), "+v"(g1[3]));
                {   float x[4][8];
#pragma unroll
                    for (int mt = 0; mt < 4; ++mt)
#pragma unroll
                        for (int e = 0; e < 8; ++e) x[mt][e] = bias[e];
#pragma unroll
                    for (int rr = 0; rr < 16; ++rr) { const f32x4 w0 = *(const LAS f32x4*)(WQ + (qd * 16 + rr) * 8), w1 = *(const LAS f32x4*)(WQ + (qd * 16 + rr) * 8 + 4);
#pragma unroll
                        for (int mt = 0; mt < 4; ++mt) { const float gkv = bf2f((bf16)(rr < 8 ? g0[mt][rr & 7] : g1[mt][rr & 7]));
#pragma unroll
                            for (int e = 0; e < 4; ++e) { x[mt][e] += gkv * w0[e]; x[mt][4 + e] += gkv * w1[e]; } } }
#pragma unroll
                    for (int mt = 0; mt < 4; ++mt)
#pragma unroll
                        for (int e = 0; e < 8; ++e) la[mt][e] = fast_logsigmoid(x[mt][e]) * (1.0f / 16.0f); }
#pragma unroll
                for (int c8 = 0; c8 < 8; ++c8)
#pragma unroll
                    for (int e = 0; e < 8; ++e) VT[(8 * (lane & 7) + e) * 72 + 8 * c8 + (lane >> 3)] = (bf16)vv[c8][e];
            }
#pragma unroll
            for (int mt = 0; mt < 4; ++mt) { const bf16* prow = P + (size_t)(tbase + tsgn * (16 * mt + r)) * LDP + OBc; qf[mt] = *(const GAS bf16x8*)(prow + h * 32 + 8 * qd); kf[mt] = *(const GAS bf16x8*)(prow + 128 + h * 32 + 8 * qd); }
#pragma unroll
            for (int mt = 0; mt < 4; ++mt)
#pragma unroll
                for (int e = 0; e < 8; ++e) { float v = la[mt][e];
                    v += dpp_f<0x111>(v); v += dpp_f<0x112>(v); v += dpp_f<0x114>(v); v += dpp_f<0x118>(v);
                    la[mt][e] = v; }
#pragma unroll
            for (int e = 0; e < 8; ++e) totv[e] = 0.f;
#pragma unroll
            for (int mt = 0; mt < 4; ++mt) {
#pragma unroll
                for (int e = 0; e < 8; ++e) la[mt][e] += totv[e];
#pragma unroll
                for (int e = 0; e < 8; ++e) totv[e] = bperm_f(lane | 15, la[mt][e]);
                if (mt == 1) {
#pragma unroll
                    for (int e = 0; e < 8; ++e) refv[e] = totv[e]; } }
#pragma unroll
            for (int mt = 0; mt < 4; ++mt) { float qv[8], kv[8];
#pragma unroll
                for (int e = 0; e < 8; ++e) { const float dl = la[mt][e] - refv[e]; qv[e] = bf2f((bf16)qf[mt][e]) * qscale * __expf(dl); kv[e] = bf2f((bf16)kf[mt][e]) * __expf(-dl); }
                qf[mt] = pack8(qv); kf[mt] = pack8(kv);
#pragma unroll
                for (int e = 0; e < 8; ++e) KT[(8 * qd + e) * 72 + 16 * mt + r] = (bf16)kf[mt][e]; }
            if (r == 0) {
#pragma unroll
                for (int e = 0; e < 8; ++e) { VTOT[8 * qd + e] = totv[e]; VSC[8 * qd + e] = totv[e] - refv[e]; } }
        }
        LDS_WAIT(); asm volatile("" ::: "memory");
        PMARK(3, false); PMARK(4, true);
        f32x4 oacc[4][4];
#pragma unroll
        for (int vt = 0; vt < 4; ++vt)
#pragma unroll
            for (int it = 0; it < 4; ++it) oacc[vt][it] = (f32x4){0.f, 0.f, 0.f, 0.f};
#pragma unroll
        for (int s = 0; s < 2; ++s) {
            bf16x8 afr[4];
#pragma unroll
            for (int vt = 0; vt < 4; ++vt) { const unsigned long long lo8 = *(const LAS unsigned long long*)(VT + (16 * vt + r) * 72 + 32 * s + 4 * qd), hi8 = *(const LAS unsigned long long*)(VT + (16 * vt + r) * 72 + 32 * s + 16 + 4 * qd);
                v4u w; w.x = (unsigned)lo8; w.y = (unsigned)(lo8 >> 32); w.z = (unsigned)hi8; w.w = (unsigned)(hi8 >> 32); afr[vt] = __builtin_bit_cast(bf16x8, w); }
#pragma unroll
            for (int it = 0; it < 4; ++it) {
                f32x4 c0 = __builtin_amdgcn_mfma_f32_16x16x32_bf16(kf[2 * s], qf[it], (f32x4){0.f, 0.f, 0.f, 0.f}, 0, 0, 0);
                f32x4 c1 = __builtin_amdgcn_mfma_f32_16x16x32_bf16(kf[2 * s + 1], qf[it], (f32x4){0.f, 0.f, 0.f, 0.f}, 0, 0, 0);
                float pv[8];
#pragma unroll
                for (int e = 0; e < 4; ++e) { const int j0 = 32 * s + 4 * qd + e, j1 = j0 + 16, i = 16 * it + r;
                    const bool k0 = j0 <= i, k1 = j1 <= i;
                    pv[e] = k0 ? c0[e] : 0.f; pv[4 + e] = k1 ? c1[e] : 0.f; }
                const bf16x8 pb = pack8(pv);
#pragma unroll
                for (int vt = 0; vt < 4; ++vt) oacc[vt][it] = __builtin_amdgcn_mfma_f32_16x16x32_bf16(afr[vt], pb, oacc[vt][it], 0, 0, 0);
            }
        }
        {   f32x4 uacc[2][4];
#pragma unroll
            for (int kt = 0; kt < 2; ++kt)
#pragma unroll
                for (int vt = 0; vt < 4; ++vt) uacc[kt][vt] = (f32x4){0.f, 0.f, 0.f, 0.f};
#pragma unroll
            for (int s = 0; s < 2; ++s) { bf16x8 ka[2], vb[4];
#pragma unroll
                for (int kt = 0; kt < 2; ++kt) ka[kt] = *(const LAS bf16x8*)(KT + (16 * kt + r) * 72 + 32 * s + 8 * qd);
#pragma unroll
                for (int vt = 0; vt < 4; ++vt) vb[vt] = *(const LAS bf16x8*)(VT + (16 * vt + r) * 72 + 32 * s + 8 * qd);
#pragma unroll
                for (int kt = 0; kt < 2; ++kt)
#pragma unroll
                    for (int vt = 0; vt < 4; ++vt) uacc[kt][vt] = __builtin_amdgcn_mfma_f32_16x16x32_bf16(ka[kt], vb[vt], uacc[kt][vt], 0, 0, 0); }
            LDS_WAIT(); asm volatile("" ::: "memory");
#pragma unroll
            for (int kt = 0; kt < 2; ++kt) { const f32x4 sc = *(const LAS f32x4*)(VSC + 16 * kt + 4 * qd);
#pragma unroll
                for (int vt = 0; vt < 4; ++vt)
#pragma unroll
                    for (int e = 0; e < 4; ++e) Ureg[(16 * kt + 4 * qd + e) * 64 + 16 * vt + r] = uacc[kt][vt][e] * __expf(sc[e]); }
        }
        PMARK(4, false); PMARK(5, true);
        LDS_BARRIER();
        if (ba < 2) {
            const int item = (ba * 4 + h) * 4 + q, base_item = item - q;
            float* AGG = (float*)(a.ws + WS_AGG + zoff) + (size_t)(l * 32) * 2 * 2112;
            gu32* flags = (gu32*)(a.ws + WS_CTL + zoff) + CW_GLAF + (l * 32) * 64;
            const int d2 = tid >> 8, k = (tid & 255) >> 3, v0 = 8 * (tid & 7);
            {
                f32x4 s0v = (f32x4){0.f, 0.f, 0.f, 0.f}, s1v = (f32x4){0.f, 0.f, 0.f, 0.f}; float lsum = 0.f;
#pragma unroll
                for (int m = 0; m < 4; ++m) { const LAS unsigned char* rm = lds + (2 * m + d2) * 16384; const float tm = ((const LAS float*)(rm + 15872))[k]; const float am = __expf(tm); lsum += tm;
                    s0v = s0v * am + *(const LAS f32x4*)((const LAS float*)rm + k * 64 + v0); s1v = s1v * am + *(const LAS f32x4*)((const LAS float*)rm + k * 64 + v0 + 4); }
                float* dst = AGG + ((size_t)item * 2 + d2) * 2112;
                *(GAS f32x4*)(dst + k * 64 + v0) = s0v; *(GAS f32x4*)(dst + k * 64 + v0 + 4) = s1v;
                if ((tid & 7) == 0) dst[2048 + k] = lsum;
            }
            asm volatile("s_waitcnt vmcnt(0)" ::: "memory");
            __syncthreads();
            if (tid == 0) { __builtin_amdgcn_fence(__ATOMIC_RELEASE, "agent"); asm volatile("s_waitcnt vmcnt(0)" ::: "memory"); __hip_atomic_store(flags + item * 64, 1u, __ATOMIC_RELAXED, __HIP_MEMORY_SCOPE_AGENT); }
            if (wave == 0) {
                for (int qq = 0; qq < 4; ++qq) { if (qq == q) continue; unsigned sp = 0;
                    while (__hip_atomic_load(flags + (base_item + qq) * 64, __ATOMIC_RELAXED, __HIP_MEMORY_SCOPE_AGENT) == 0u) { __builtin_amdgcn_s_sleep(1);
                        if (++sp > (1u << 20)) { if (lane == 0) __hip_atomic_store((gu32*)(a.ws + WS_CTL) + CW_TMO, 1u, __ATOMIC_RELAXED, __HIP_MEMORY_SCOPE_AGENT); break; } } }
                __builtin_amdgcn_fence(__ATOMIC_ACQUIRE, "agent");
                asm volatile("s_waitcnt vmcnt(0)" ::: "memory");
            }
            __syncthreads();
            {
                const float* s0p = a.in[2] + zoff + ((((size_t)ba * DEPTH + l) * 2 + d2) * 4 + h) * 2048 + k * 64 + v0;
                f32x4 s0v = *(const GAS f32x4*)s0p, s1v = *(const GAS f32x4*)(s0p + 4);
#pragma unroll 1
                for (int step = 0; step < 3; ++step) { const int qq = d2 ? 3 - step : step; const bool use = d2 ? (qq > q) : (qq < q);
                    if (use) { const float* srcp = AGG + ((size_t)(base_item + qq) * 2 + d2) * 2112; const float am = __expf(*(const GAS float*)(srcp + 2048 + k));
                        s0v = s0v * am + *(const GAS f32x4*)(srcp + k * 64 + v0); s1v = s1v * am + *(const GAS f32x4*)(srcp + k * 64 + v0 + 4); } }
                *(LAS f32x4*)(SRUN + d2 * 2048 + k * 64 + v0) = s0v; *(LAS f32x4*)(SRUN + d2 * 2048 + k * 64 + v0 + 4) = s1v;
            }
            __syncthreads();
        }
        {   float ex[8];
#pragma unroll
            for (int e = 0; e < 8; ++e) ex[e] = __expf(refv[e]);
#pragma unroll
            for (int vt = 0; vt < 4; ++vt) { float sv[8];
#pragma unroll
                for (int e = 0; e < 8; ++e) sv[e] = SRUN[dir * 2048 + (8 * qd + e) * 64 + 16 * vt + r];
                for (int m = 0; m < n; ++m) { const LAS unsigned char* rm = lds + (2 * m + dir) * 16384; const LAS float* Um = (const LAS float*)rm; const LAS float* Tm = (const LAS float*)(rm + 15872);
#pragma unroll
                    for (int e = 0; e < 8; ++e) sv[e] = __expf(Tm[8 * qd + e]) * sv[e] + Um[(8 * qd + e) * 64 + 16 * vt + r]; }
#pragma unroll
                for (int e = 0; e < 8; ++e) sv[e] *= ex[e];
                const bf16x8 sa = pack8(sv);
#pragma unroll
                for (int it = 0; it < 4; ++it) oacc[vt][it] = __builtin_amdgcn_mfma_f32_16x16x32_bf16(sa, qf[it], oacc[vt][it], 0, 0, 0); }
        }
        PMARK(5, false); PMARK(6, true);
        unsigned long long gm[2][4];
#pragma unroll
        for (int it = 0; it < 2; ++it)
#pragma unroll
            for (int vt = 0; vt < 4; ++vt) gm[it][vt] = *(const GAS unsigned long long*)(P + (size_t)(tbase + tsgn * (16 * it + r)) * LDP + OBc + 512 + h * 64 + 16 * vt + 4 * qd);
        LDS_BARRIER();
        if (ba >= 2) {   const int k = 8 * n + (lane >> 3), v0 = 8 * (lane & 7);
            f32x4 s0 = *(const LAS f32x4*)(SRUN + dir * 2048 + k * 64 + v0), s1 = *(const LAS f32x4*)(SRUN + dir * 2048 + k * 64 + v0 + 4);
#pragma unroll
            for (int m = 0; m < 4; ++m) { const LAS unsigned char* rm = lds + (2 * m + dir) * 16384; const float am = __expf(((const LAS float*)(rm + 15872))[k]);
                s0 = s0 * am + *(const LAS f32x4*)((const LAS float*)rm + k * 64 + v0); s1 = s1 * am + *(const LAS f32x4*)((const LAS float*)rm + k * 64 + v0 + 4); }
            float* so = a.out + zoff + (size_t)M * D + ((((size_t)(ba - 2) * DEPTH + l) * 2 + dir) * 4 + h) * 2048 + k * 64 + v0;
            *(GAS f32x4*)so = s0; *(GAS f32x4*)(so + 4) = s1;
        }
        LDS_BARRIER();
        LAS float* OL = (LAS float*)reg;
#pragma unroll
        for (int it = 2; it < 4; ++it)
#pragma unroll
            for (int vt = 0; vt < 4; ++vt) *(LAS f32x4*)(OL + ((it - 2) * 16 + r) * 64 + (((4 * vt + qd) ^ r) & 15) * 4) = oacc[vt][it];
        LDS_BARRIER();
        {
            const LAS float* OP = (const LAS float*)(lds + (2 * (3 - n) + (dir ^ 1)) * 16384);
            bf16* MIX = (bf16*)(a.ws + WS_MIX + zoff);
            f32x4 gnv[4];
#pragma unroll
            for (int vt = 0; vt < 4; ++vt) gnv[vt] = *(const GAS f32x4*)(a.in[15] + zoff + (size_t)l * 64 + 16 * vt + 4 * qd);
#pragma unroll
            for (int it = 0; it < 2; ++it) { float ss = 0.f; const int pr = 15 - r, pt = (1 - it) * 16 + pr;
#pragma unroll
                for (int vt = 0; vt < 4; ++vt) { const f32x4 o = oacc[vt][it] + *(const LAS f32x4*)(OP + pt * 64 + (((4 * vt + qd) ^ pr) & 15) * 4); oacc[vt][it] = o; ss += (o[0] * o[0] + o[1] * o[1]) + (o[2] * o[2] + o[3] * o[3]); }
                ss += bperm_f(lane ^ 16, ss); ss += bperm_f(lane ^ 32, ss);
                const float rn = __builtin_amdgcn_rsqf(ss * (1.0f / 64.0f) + EPS);
#pragma unroll
                for (int vt = 0; vt < 4; ++vt) { float y[4];
#pragma unroll
                    for (int e2 = 0; e2 < 4; ++e2) y[e2] = oacc[vt][it][e2] * rn * gnv[vt][e2] * silu_fast(bf2f((bf16)(gm[it][vt] >> (16 * e2))));
                    *(GAS unsigned long long*)(MIX + (size_t)(tbase + tsgn * (16 * it + r)) * D + 256 + h * 64 + 16 * vt + 4 * qd) = (unsigned long long)pk2(y[0], y[1]) | ((unsigned long long)pk2(y[2], y[3]) << 32); } }
        }
    }
    LDS_BARRIER();
    PMARK(6, false); PMARK(1, false);
}

__device__ __forceinline__ void mlp_mfma_item(const Args& a, int l, int chunk, LAS unsigned char* lds, int tid, int wave) {
    const int r0 = chunk * 128, lane = tid & 63, r = lane & 15, qd = lane >> 4;
    const bf16* P = (const bf16*)(a.ws + WS_P); bf16* MIX = (bf16*)(a.ws + WS_MIX);
    LAS bf16* VVT = (LAS bf16*)lds;
    PMARK(20, true); PMARK(21, true);
    {   const int j = tid >> 2, part = tid & 3;
        const bf16* prow = P + (size_t)(r0 + j) * LDP + OCc + 256 + part * 64;
        float v[64]; float s = 0.f;
#pragma unroll
        for (int e8 = 0; e8 < 8; ++e8) { const bf16x8 raw = *(const GAS bf16x8*)(prow + 8 * e8);
#pragma unroll
            for (int e = 0; e < 8; ++e) { const float x = gelu_fast(bf2f((bf16)raw[e])); v[8 * e8 + e] = x; s += x; } }
        s += dpp_f<0xB1>(s); s += dpp_f<0x4E>(s);
        const float mu = s * (1.0f / 256.0f); float q = 0.f;
#pragma unroll
        for (int e = 0; e < 64; ++e) { const float d = v[e] - mu; q += d * d; }
        q += dpp_f<0xB1>(q); q += dpp_f<0x4E>(q);
        const float rstd = 1.0f / sqrtf(q * (1.0f / 256.0f) + EPS);
        const float* lg = a.in[16] + (size_t)l * 256 + part * 64;
#pragma unroll
        for (int e = 0; e < 64; ++e) VVT[(part * 64 + e) * 136 + j] = (bf16)f2bf((v[e] - mu) * rstd * lg[e]);
    }
    LDS_BARRIER();
    PMARK(21, false); PMARK(22, true);
    {   const int g = wave >> 1, ih = wave & 1;
        const float* wsg = a.in[17] + ((size_t)l * 4 + g) * 128 * 128;
        f32x4 acc[4][4];
#pragma unroll
        for (int ct = 0; ct < 4; ++ct)
#pragma unroll
            for (int it = 0; it < 4; ++it) acc[ct][it] = (f32x4){0.f, 0.f, 0.f, 0.f};
#pragma unroll 1
        for (int sp = 0; sp < 2; ++sp) {
            bf16x8 bfr[4][2];
            {   f32x4 w0[4][2], w1[4][2];
#pragma unroll
                for (int it = 0; it < 4; ++it)
#pragma unroll
                    for (int s2 = 0; s2 < 2; ++s2) { const float* wr = wsg + (size_t)(64 * ih + 16 * it + r) * 128 + 32 * (2 * sp + s2) + 8 * qd; w0[it][s2] = *(const GAS f32x4*)wr; w1[it][s2] = *(const GAS f32x4*)(wr + 4); }
#pragma unroll
                for (int it = 0; it < 4; ++it)
#pragma unroll
                    for (int s2 = 0; s2 < 2; ++s2) { v4u w; w.x = pk2(w0[it][s2][0], w0[it][s2][1]); w.y = pk2(w0[it][s2][2], w0[it][s2][3]); w.z = pk2(w1[it][s2][0], w1[it][s2][1]); w.w = pk2(w1[it][s2][2], w1[it][s2][3]); bfr[it][s2] = __builtin_bit_cast(bf16x8, w); } }
#pragma unroll
            for (int s2 = 0; s2 < 2; ++s2) { bf16x8 af[4];
#pragma unroll
                for (int ct = 0; ct < 4; ++ct) af[ct] = *(const LAS bf16x8*)(VVT + (64 * g + 16 * ct + r) * 136 + 32 * (2 * sp + s2) + 8 * qd);
#pragma unroll
                for (int it = 0; it < 4; ++it)
#pragma unroll
                    for (int ct = 0; ct < 4; ++ct) acc[ct][it] = __builtin_amdgcn_mfma_f32_16x16x32_bf16(af[ct], bfr[it][s2], acc[ct][it], 0, 0, 0); } }
        unsigned long long um[4][4];
#pragma unroll
        for (int it = 0; it < 4; ++it)
#pragma unroll
            for (int ct = 0; ct < 4; ++ct) um[it][ct] = *(const GAS unsigned long long*)(P + (size_t)(r0 + 64 * ih + 16 * it + r) * LDP + OCc + 64 * g + 16 * ct + 4 * qd);
        asm volatile("" : "+v"(um[0][0]), "+v"(um[1][0]), "+v"(um[2][0]), "+v"(um[3][3]));
        PMARK(22, false); PMARK(23, true);
        const float* bs = a.in[18] + ((size_t)l * 4 + g) * 128;
#pragma unroll
        for (int it = 0; it < 4; ++it) { const int i = 64 * ih + 16 * it + r; const float bsi = bs[i]; const size_t row = (size_t)(r0 + i);
#pragma unroll
            for (int ct = 0; ct < 4; ++ct) { const int c = 64 * g + 16 * ct + 4 * qd;
                float y[4];
#pragma unroll
                for (int e = 0; e < 4; ++e) y[e] = gelu_fast(bf2f((bf16)(um[it][ct] >> (16 * e)))) * (acc[ct][it][e] + bsi);
                *(GAS unsigned long long*)(MIX + row * D + 512 + c) = (unsigned long long)pk2(y[0], y[1]) | ((unsigned long long)pk2(y[2], y[3]) << 32); } }
    }
    LDS_BARRIER();
    PMARK(23, false); PMARK(20, false);
}

__device__ __forceinline__ void aconv_item(const Args& a, int l, int item, int tid) {
    const bf16* P = (const bf16*)(a.ws + WS_P); bf16* MIX = (bf16*)(a.ws + WS_MIX);
    const float* ca = a.in[12] + (size_t)l * 768;
    const int c8 = 8 * (tid & 31);
    float w[3][8];
#pragma unroll
    for (int d = 0; d < 3; ++d)
#pragma unroll
        for (int e = 0; e < 8; ++e) w[d][e] = ca[d * 256 + c8 + e];
#pragma unroll
    for (int i = 0; i < 4; ++i) { const int row = item * 64 + (tid >> 5) + 16 * i;
        const int wpos = (row < NCTX) ? (row & 255) : ((row - NCTX) & 63); const int row_w = (row < NCTX) ? LC : GRIDW;
        const bf16* p = P + (size_t)row * LDP;
        float s[8];
#pragma unroll
        for (int e = 0; e < 8; ++e) s[e] = 0.f;
#pragma unroll
        for (int d = -1; d <= 1; ++d) { if (wpos + d >= 0 && wpos + d < row_w) { const bf16x8 cg = *(const GAS bf16x8*)(p + d * LDP + 256 + c8), xa = *(const GAS bf16x8*)(p + d * LDP + 512 + c8);
#pragma unroll
                for (int e = 0; e < 8; ++e) s[e] += w[d + 1][e] * bf2f((bf16)cg[e]) * bf2f((bf16)xa[e]); } }
        const bf16x8 bg = *(const GAS bf16x8*)(p + c8); float y[8];
#pragma unroll
        for (int e = 0; e < 8; ++e) y[e] = bf2f((bf16)bg[e]) * s[e];
        *(GAS bf16x8*)(MIX + (size_t)row * D + c8) = pack8(y); }
}

#define LAUNDER_TID() int zz_ = 0; asm volatile("" : "+s"(zz_)); const int lane = (int)__builtin_amdgcn_mbcnt_hi(~0u, __builtin_amdgcn_mbcnt_lo(~0u, (unsigned)zz_)); const int tid = wave * 64 + lane; (void)lane
template <int PARTS = 31>
__device__ __forceinline__ void mix_heavy_phase(const Args& a, int l, LAS unsigned char* lds, int G, int wave, int tid_in) {
    const int bx = blockIdx.x;
    volatile LAS unsigned* qslot = (volatile LAS unsigned*)(lds + MISC_OFF + 64);
    gu32* head = (gu32*)(a.ws + WS_CTL) + CW_QHEAD + 64 * l;
    const int nstatic = G - 32;
    int k = -1;
    if (bx < 32) { if (PARTS & 1) { LAUNDER_TID(); gla_mfma_item(a, l, bx >> 4, (bx >> 2) & 3, bx & 3, lds, tid, wave); } }
    else k = bx - 32;
#pragma unroll 1
    for (;;) {
        if (k < 0) {
            LAUNDER_TID();
            if (tid == 0) qslot[0] = (unsigned)nstatic + __hip_atomic_fetch_add(head, 1u, __ATOMIC_RELAXED, __HIP_MEMORY_SCOPE_AGENT);
            LDS_BARRIER();
            k = (int)qslot[0];
            LDS_BARRIER();
        }
        if (k >= 560) break;
        {   LAUNDER_TID();
            if (k < 64) { if (PARTS & 2) hyena_mfma_item<1>(a, l, k, lds, tid, wave); }
            else if (k < 192) { if (PARTS & 16) gla_mfma_item(a, l, 2 + ((k - 64) >> 2), (k - 64) & 3, 0, lds, tid, wave); }
            else if (k < 320) { if (PARTS & 4) hyena_mfma_item<0>(a, l, k - 192, lds, tid, wave); }
            else if (k < 400) { if (PARTS & 8) mlp_mfma_item(a, l, k - 320, lds, tid, wave); }
            else { if (PARTS & 8) aconv_item(a, l, k - 400, tid); }
        }
        k = -1;
    }
}

__global__ void __launch_bounds__(NTHREADS, 2) fwd_kernel(Args args) {
    extern __shared__ __attribute__((aligned(16))) unsigned char lds_raw[];
    LAS unsigned char* lds = (LAS unsigned char*)lds_raw;
    volatile LAS unsigned* MISC = (volatile LAS unsigned*)(lds + MISC_OFF);
    const int tid = threadIdx.x, lane = tid & 63, wave = __builtin_amdgcn_readfirstlane(tid >> 6);
    const int G = gridDim.x; const int bx = blockIdx.x; const int vcu = (G % 8 == 0) ? (bx % 8) * (G / 8) + bx / 8 : bx;
    gu32* ctl = (gu32*)(args.ws + WS_CTL);
    for (int u = tid; u < (LDS_BYTES - LDSCTL_OFF) / 4; u += NTHREADS) ((LAS unsigned*)(lds + LDSCTL_OFF))[u] = 0u;
    __syncthreads();
    XcdBarrier bar; bar.bar = (unsigned*)(ctl + CW_BAR); bar.x = 0; bar.st = nullptr;
    if (!MK_PER_PHASE) bar = xcd_barrier_post((unsigned*)(ctl + CW_BAR), MISC + 8);
    const int lo = args.ph_lo, hi = args.ph_hi;
#define PH_BEGIN(k) if (lo <= (k) && (k) < hi) { int zero_o = 0; asm volatile("" : "+s"(zero_o)); \
        const int lane_o = (int)__builtin_amdgcn_mbcnt_hi(~0u, __builtin_amdgcn_mbcnt_lo(~0u, (unsigned)zero_o)); const int tid_o = wave * 64 + lane_o; (void)tid_o; probe_mark(args.ws, 100 + (k), true, wave, 0);
#define PH_END(k) if ((k) + 1 < hi) { XcdBarrier barp = bar; asm volatile("" : "+s"(barp.bar)); xcd_barrier(barp, tid_o); } probe_mark(args.ws, 100 + (k), false, wave, 0); }
#define DUP_BEGIN() { int zero_o = 0; asm volatile("" : "+s"(zero_o)); \
        const int lane_o = (int)__builtin_amdgcn_mbcnt_hi(~0u, __builtin_amdgcn_mbcnt_lo(~0u, (unsigned)zero_o)); const int tid_o = wave * 64 + lane_o; (void)tid_o;
#define DUP_END() { XcdBarrier barp = bar; asm volatile("" : "+s"(barp.bar)); xcd_barrier(barp, tid_o); } }
    PH_BEGIN(0) p0_prologue(args, lds, vcu, G, wave, lane_o, tid_o); PH_END(0)
#if PROBE_KIND == 100
    DUP_BEGIN() p0_prologue(args, lds, vcu, G, wave, lane_o, tid_o); DUP_END()
#endif
#if PROBE_KIND == 101
    DUP_BEGIN() p1_table_phase(args, vcu, G, wave, lane_o); row_phase(args, 0, 0, vcu, G, wave, lane_o); DUP_END()
#endif
#if PROBE_KIND == 102
    DUP_BEGIN() mix_heavy_phase(args, 0, lds, G, wave, tid_o); DUP_END()
#endif
#if PROBE_KIND == 103
    DUP_BEGIN() { unsigned char* wl = args.ws + WS_W; pg8::Gemm g{(const pg8::bf16_t*)(args.ws + WS_H), (const pg8::bf16_t*)(wl + W_13), M, 2 * FF, D}; pg8::StaticOrder S; S.init(M, 2 * FF, G, bx);
        pg8::EpiSwiGLU E{(pg8::bf16_t*)(args.ws + WS_P), FF};
        pg8::gemm_phase<pg8::EpiSwiGLU, pg8::StaticOrder, true, true>(lds + RING_OFF, g, S, E, tid_o); } DUP_END()
#endif
#if PROBE_KIND == 104
    DUP_BEGIN() { unsigned char* wl = args.ws + WS_W; pg8::Gemm g{(const pg8::bf16_t*)(args.ws + WS_P), (const pg8::bf16_t*)(wl + W_2), M, D, FF}; pg8::StaticOrder S; S.init(M, D, G, bx);
        pg8::EpiF32 E{(float*)(args.ws + WS_MF), D};
        pg8::gemm_phase<pg8::EpiF32, pg8::StaticOrder, true, true>(lds + RING_OFF, g, S, E, tid_o); } DUP_END()
#endif
#if PROBE_KIND == 105
    DUP_BEGIN() row_phase(args, 0, 0, vcu, G, wave, lane_o); DUP_END()
#endif
#if PROBE_KIND == 106
    DUP_BEGIN() DUP_END()
    DUP_BEGIN() DUP_END()
    DUP_BEGIN() DUP_END()
    DUP_BEGIN() DUP_END()
#endif
#if PROBE_KIND >= 200 && PROBE_KIND < 232
#define HEAVY_DUP(l) DUP_BEGIN() mix_heavy_phase<PROBE_KIND - 200>(args, l, lds, G, wave, tid_o); DUP_END()
#else
#define HEAVY_DUP(l)
#endif
#if PROBE_KIND == 301
#define G1_DUP(l) DUP_BEGIN() { unsigned char* wl = args.ws + WS_W + (size_t)(l) * W_LAYER; pg8::Gemm g{(const pg8::bf16_t*)(args.ws + WS_H), (const pg8::bf16_t*)(wl + W_IN), M, INP, D}; pg8::StaticOrder S; S.init(M, INP, G, bx); \
        pg8::EpiP E{(pg8::bf16_t*)(args.ws + WS_P), (pg8::bf16_t*)(args.ws + WS_PHY), LDP, M}; pg8::gemm_phase<pg8::EpiP, pg8::StaticOrder, true, true>(lds + RING_OFF, g, S, E, tid_o); } DUP_END()
#else
#define G1_DUP(l)
#endif
#if PROBE_KIND == 3020
#define G3_DUP(l) DUP_BEGIN() { unsigned char* wl = args.ws + WS_W + (size_t)(l) * W_LAYER; pg8::Gemm g{(const pg8::bf16_t*)(args.ws + WS_H), (const pg8::bf16_t*)(wl + W_OUT), M, D, D}; pg8::StaticOrder S; S.init(M, D, G, bx); \
        pg8::EpiF32 E{(float*)(args.ws + WS_MF), D}; pg8::gemm_phase<pg8::EpiF32, pg8::StaticOrder, true, true>(lds + RING_OFF, g, S, E, tid_o); } DUP_END()
#elif PROBE_KIND == 3040
#define G3_DUP(l) DUP_BEGIN() { unsigned char* wl = args.ws + WS_W + (size_t)(l) * W_LAYER; pg8::Gemm g{(const pg8::bf16_t*)(args.ws + WS_P), (const pg8::bf16_t*)(wl + W_2), M, D, FF}; pg8::StaticOrder S; S.init(M, D, G, bx); \
        pg8::EpiF32 E{(float*)(args.ws + WS_MF), D}; pg8::gemm_phase<pg8::EpiF32, pg8::StaticOrder, true, true>(lds + RING_OFF, g, S, E, tid_o); } DUP_END()
#elif PROBE_KIND == 303
#define G3_DUP(l) DUP_BEGIN() { unsigned char* wl = args.ws + WS_W + (size_t)(l) * W_LAYER; pg8::Gemm g{(const pg8::bf16_t*)(args.ws + WS_H), (const pg8::bf16_t*)(wl + W_13), M, 2 * FF, D}; pg8::StaticOrder S; S.init(M, 2 * FF, G, bx); \
        pg8::EpiSwiGLU E{(pg8::bf16_t*)(args.ws + WS_P), FF}; pg8::gemm_phase<pg8::EpiSwiGLU, pg8::StaticOrder, true, true>(lds + RING_OFF, g, S, E, tid_o); } DUP_END()
#else
#define G3_DUP(l)
#endif
#if PROBE_KIND == 305
#define ROW_DUP(l) if ((l) == 0) { DUP_BEGIN() row_phase(args, 0, 1, vcu, G, wave, lane_o); DUP_END() DUP_BEGIN() row_phase(args, 0, 1, vcu, G, wave, lane_o); DUP_END() }
#else
#define ROW_DUP(l)
#endif
#define LAYER(l, B) \
    PH_BEGIN(B + 0) { unsigned char* wl = args.ws + WS_W + (size_t)(l) * W_LAYER; \
        pg8::Gemm g{(const pg8::bf16_t*)(args.ws + WS_H), (const pg8::bf16_t*)(wl + W_IN), M, INP, D}; pg8::StaticOrder S; S.init(M, INP, G, bx); \
        pg8::EpiP E{(pg8::bf16_t*)(args.ws + WS_P), (pg8::bf16_t*)(args.ws + WS_PHY), LDP, M}; \
        pg8::gemm_phase<pg8::EpiP, pg8::StaticOrder, true, true>(lds + RING_OFF, g, S, E, tid_o); \
        if ((l) == 0 && bx >= 224 && bx < 240) { int zz_ = 0; asm volatile("" : "+s"(zz_)); const int lane2 = (int)__builtin_amdgcn_mbcnt_hi(~0u, __builtin_amdgcn_mbcnt_lo(~0u, (unsigned)zz_)); \
            __syncthreads(); late_filter_item(args, 144 + (bx - 224), lds, wave, lane2, wave * 64 + lane2); } \
        if ((l) == 0 && bx >= 240) { int zz_ = 0; asm volatile("" : "+s"(zz_)); const int lane2 = (int)__builtin_amdgcn_mbcnt_hi(~0u, __builtin_amdgcn_mbcnt_lo(~0u, (unsigned)zz_)); \
            convert_items(args, 0, C_IN, C_OUT, (bx - 240) * NWAVES + wave, 16 * NWAVES, (LAS float*)(lds + RING_OFF + wave * 16384), lane2); } \
        if ((l) == 1 && bx >= 224) { int zz_ = 0; asm volatile("" : "+s"(zz_)); const int lane2 = (int)__builtin_amdgcn_mbcnt_hi(~0u, __builtin_amdgcn_mbcnt_lo(~0u, (unsigned)zz_)); \
            convert_items(args, 1, C_IN, C_OUT, (bx - 224) * NWAVES + wave, 32 * NWAVES, (LAS float*)(lds + RING_OFF + wave * 16384), lane2); } } PH_END(B + 0) \
    G1_DUP(l) \
    PH_BEGIN(B + 1) mix_heavy_phase(args, l, lds, G, wave, tid_o); \
PH_END(B + 1) \
    HEAVY_DUP(l) \
    PH_BEGIN(B + 2) { unsigned char* wl = args.ws + WS_W + (size_t)(l) * W_LAYER; \
        pg8::Gemm g{(const pg8::bf16_t*)(args.ws + WS_MIX), (const pg8::bf16_t*)(wl + W_OUT), M, D, D}; pg8::StaticOrder S; S.init(M, D, G, bx); \
        pg8::EpiBf16<0> E{(pg8::bf16_t*)(args.ws + WS_MF), D, nullptr, 0, 0, 1.f}; \
        pg8::gemm_phase<pg8::EpiBf16<0>, pg8::StaticOrder, true, true>(lds + RING_OFF, g, S, E, tid_o); \
        if (bx >= 160) { int zz_ = 0; asm volatile("" : "+s"(zz_)); const int lane2 = (int)__builtin_amdgcn_mbcnt_hi(~0u, __builtin_amdgcn_mbcnt_lo(~0u, (unsigned)zz_)); \
            convert_items(args, (l), C_OUT, C_13, (bx - 160) * NWAVES + wave, (G - 160) * NWAVES, (LAS float*)(lds + RING_OFF + wave * 16384), lane2); } } PH_END(B + 2) \
    PH_BEGIN(B + 3) row_phase(args, l, 1, vcu, G, wave, lane_o); PH_END(B + 3) \
    ROW_DUP(l) \
    PH_BEGIN(B + 4) { unsigned char* wl = args.ws + WS_W + (size_t)(l) * W_LAYER; \
        pg8::Gemm g{(const pg8::bf16_t*)(args.ws + WS_H), (const pg8::bf16_t*)(wl + W_13), M, 2 * FF, D}; pg8::StaticOrder S; S.init(M, 2 * FF, G, bx); \
        pg8::EpiSwiGLU E{(pg8::bf16_t*)(args.ws + WS_P), FF}; \
        pg8::gemm_phase<pg8::EpiSwiGLU, pg8::StaticOrder, true, true>(lds + RING_OFF, g, S, E, tid_o); \
        if (bx >= 112) { int zz_ = 0; asm volatile("" : "+s"(zz_)); const int lane2 = (int)__builtin_amdgcn_mbcnt_hi(~0u, __builtin_amdgcn_mbcnt_lo(~0u, (unsigned)zz_)); \
            convert_items(args, (l), C_13, C_2, (bx - 112) * NWAVES + wave, (G - 112) * NWAVES, (LAS float*)(lds + RING_OFF + wave * 16384), lane2); \
            if ((l) == 0) { __syncthreads(); late_filter_item(args, bx - 112, lds, wave, lane2, wave * 64 + lane2); } } } PH_END(B + 4) \
    G3_DUP(l) \
    PH_BEGIN(B + 5) { unsigned char* wl = args.ws + WS_W + (size_t)(l) * W_LAYER; \
        pg8::Gemm g{(const pg8::bf16_t*)(args.ws + WS_P), (const pg8::bf16_t*)(wl + W_2), M, D, FF}; pg8::StaticOrder S; S.init(M, D, G, bx); \
        if ((l) == DEPTH - 1) { pg8::SplitOrder S2; S2.init(M, D, G, bx, G4_KTM, FF / 64); pg8::EpiBf16Part E2{(pg8::bf16_t*)(args.ws + WS_MF), (pg8::bf16_t*)(args.ws + WS_MF2), D}; \
            pg8::gemm_phase<pg8::EpiBf16Part, pg8::SplitOrder, true, true>(lds + RING_OFF, g, S2, E2, tid_o); } \
        else { pg8::EpiBf16<0> E{(pg8::bf16_t*)(args.ws + WS_MF), D, nullptr, 0, 0, 1.f}; \
        pg8::gemm_phase<pg8::EpiBf16<0>, pg8::StaticOrder, true, true>(lds + RING_OFF, g, S, E, tid_o); } \
        if ((l) == 0 && bx >= 160) { int zz_ = 0; asm volatile("" : "+s"(zz_)); const int lane2 = (int)__builtin_amdgcn_mbcnt_hi(~0u, __builtin_amdgcn_mbcnt_lo(~0u, (unsigned)zz_)); \
            late_mod_item(args, bx - 160, lds, wave, lane2, wave * 64 + lane2); \
            convert_items(args, 1, 0, C_IN, (bx - 160) * NWAVES + wave, (G - 160) * NWAVES, (LAS float*)(lds + RING_OFF + wave * 16384), lane2); } } PH_END(B + 5) \
    PH_BEGIN(B + 6) row_phase(args, l, 2, vcu, G, wave, lane_o); PH_END(B + 6)
    LAYER(0, 1)
    LAYER(1, 8)
#undef LAYER
#undef PH_BEGIN
#undef PH_END
    probe_stretch(args.ws, wave);
}

extern "C" void kernel_launch(void* const* d_in, const int* in_sizes, int n_in, void* d_out, int out_size, void* d_ws, size_t ws_size, hipStream_t stream) {
    static int grid = 0;
    if (grid == 0) {
        if (n_in != 32 || ws_size < WS_END) { fprintf(stderr, "kernel_launch: unexpected inputs (n_in %d, ws %zu)\n", n_in, ws_size); grid = -1; return; }
        int dev = 0, cus = 0, per_cu = 0;
        if (hipGetDevice(&dev) != hipSuccess || hipDeviceGetAttribute(&cus, hipDeviceAttributeMultiprocessorCount, dev) != hipSuccess) { grid = -1; return; }
        if (hipFuncSetAttribute((const void*)fwd_kernel, hipFuncAttributeMaxDynamicSharedMemorySize, LDS_BYTES) != hipSuccess) { fprintf(stderr, "kernel_launch: hipFuncSetAttribute failed\n"); grid = -1; return; }
        if (hipOccupancyMaxActiveBlocksPerMultiprocessor(&per_cu, (const void*)fwd_kernel, NTHREADS, LDS_BYTES) != hipSuccess || per_cu < 1) { fprintf(stderr, "kernel_launch: occupancy query says %d blocks per CU\n", per_cu); }
        (void)hipGetLastError();
        grid = 256;
        if (cus < 256 || per_cu < 1) fprintf(stderr, "kernel_launch: this kernel needs 256 CUs with one resident workgroup each (device reports %d CUs, %d workgroups per CU)\n", cus, per_cu);
    }
    if (grid < 0) return;
    (void)hipMemsetAsync((char*)d_ws + WS_CTL, 0, CTL_ZERO_BYTES, stream);
    Args a{};
    for (int i = 0; i < 32; ++i) a.in[i] = (const float*)d_in[i];
    a.out = (float*)d_out; a.ws = (unsigned char*)d_ws;
#if MK_PER_PHASE
    for (int p = 0; p < NPHASE; ++p) { a.ph_lo = p; a.ph_hi = p + 1; a.li = p; hipLaunchKernelGGL(fwd_kernel, dim3(grid), dim3(NTHREADS), LDS_BYTES, stream, a); }
#else
    a.ph_lo = 0; a.ph_hi = NPHASE; a.li = 0;
    hipLaunchKernelGGL(fwd_kernel, dim3(grid), dim3(NTHREADS), LDS_BYTES, stream, a);
#endif
}
```
